# Optimizing an MI355X kernel written in HIP

```python
import jax, jax.numpy as jnp
from jax import lax
import numpy as np

D_MODEL = 1024
BATCH = 8
SEQ = 8192
DEPTH = 4

GRID_W = 64
CTX_LEN = 256
N_HEADS = 16
HEAD_DIM = D_MODEL // N_HEADS
NA_ROWS = 8
NA_COLS = 16
CONV_WIDTH = 3
FFN_HIDDEN = -(-8 * D_MODEL // (3 * 256)) * 256
EPS = 1e-6
NEG_INF = -1e30

kernel_name = "hybrid_conv_natten_prefix_dit"


def _rms_norm(x, g):
    xf = x.astype(jnp.float32)
    y = xf * lax.rsqrt(jnp.mean(xf * xf, axis=-1, keepdims=True) + EPS)
    return (y * g.astype(jnp.float32)).astype(x.dtype)


def _modulate(h, shift, scale):
    return h * (1 + scale) + shift


def _swiglu(h, w_in, w_out):
    gate, up = jnp.split(h @ w_in, 2, axis=-1)
    return (jax.nn.silu(gate) * up) @ w_out


def _short_conv_mixer(h, w_in, conv_w, w_out):
    b_gate, c_gate, u = jnp.split(h @ w_in, 3, axis=-1)
    z = c_gate * u
    n = z.shape[1]
    pad = CONV_WIDTH // 2
    zp = jnp.pad(z, ((0, 0), (pad, pad), (0, 0)))
    zc = sum(conv_w[j] * zp[:, j:j + n] for j in range(CONV_WIDTH))
    return (b_gate * zc) @ w_out


def _qkv_heads(h, w_qkv, g_q, g_k):
    q, k, v = jnp.split(h @ w_qkv, 3, axis=-1)
    shp = h.shape[:-1] + (N_HEADS, HEAD_DIM)
    return _rms_norm(q.reshape(shp), g_q), _rms_norm(k.reshape(shp), g_k), v.reshape(shp)


def _neighbourhood_attention(h, hc, w_qkv, g_q, g_k, rpb, w_out, with_ctx_out):
    bsz, n, _ = h.shape
    rows = n // GRID_W
    kh = min(NA_ROWS, rows)
    scale = HEAD_DIM ** -0.5
    q, k, v = _qkv_heads(h, w_qkv, g_q, g_k)
    qc, kc, vc = _qkv_heads(hc, w_qkv, g_q, g_k)
    q_g = q.reshape(bsz, rows, GRID_W, N_HEADS, HEAD_DIM)
    k_g = k.reshape(bsz, rows, GRID_W, N_HEADS, HEAD_DIM)
    v_g = v.reshape(bsz, rows, GRID_W, N_HEADS, HEAD_DIM)

    col = jnp.arange(GRID_W)
    col_start = jnp.clip(col - NA_COLS // 2, 0, GRID_W - NA_COLS)
    col_ok = (col[None, :] >= col_start[:, None]) & (col[None, :] < col_start[:, None] + NA_COLS)
    dc = jnp.clip(col[None, :] - col[:, None] + NA_COLS - 1, 0, 2 * NA_COLS - 2)

    def row_block(r):
        r_start = jnp.clip(r - kh // 2, 0, rows - kh)
        q_r = lax.dynamic_index_in_dim(q_g, r, axis=1, keepdims=False)
        k_r = lax.dynamic_slice_in_dim(k_g, r_start, kh, axis=1)
        v_r = lax.dynamic_slice_in_dim(v_g, r_start, kh, axis=1)
        dr = r_start + jnp.arange(kh) - r + NA_ROWS - 1
        bias = rpb[:, dr][:, :, dc].astype(jnp.float32)
        bias = jnp.where(col_ok[None, None], bias, NEG_INF).transpose(0, 2, 1, 3)
        s_win = jnp.einsum('bqhd,brkhd->bhqrk', q_r, k_r,
                           preferred_element_type=jnp.float32) * scale + bias[None]
        s_ctx = jnp.einsum('bqhd,bchd->bhqc', q_r, kc,
                           preferred_element_type=jnp.float32) * scale
        s = jnp.concatenate([s_win.reshape(bsz, N_HEADS, GRID_W, kh * GRID_W), s_ctx], axis=-1)
        p = jax.nn.softmax(s, axis=-1).astype(v.dtype)
        p_win = p[..., :kh * GRID_W].reshape(bsz, N_HEADS, GRID_W, kh, GRID_W)
        p_ctx = p[..., kh * GRID_W:]
        return (jnp.einsum('bhqrk,brkhd->bqhd', p_win, v_r)
                + jnp.einsum('bhqc,bchd->bqhd', p_ctx, vc))

    o = lax.map(row_block, jnp.arange(rows))
    o = jnp.moveaxis(o, 0, 1).reshape(bsz, n, D_MODEL)
    y = o @ w_out
    if not with_ctx_out:
        return y, None
    sc = jnp.einsum('bqhd,bkhd->bhqk', qc, kc, preferred_element_type=jnp.float32) * scale
    pc = jax.nn.softmax(sc, axis=-1).astype(vc.dtype)
    oc = jnp.einsum('bhqk,bkhd->bqhd', pc, vc).reshape(bsz, hc.shape[1], D_MODEL)
    return y, oc @ w_out


def setup_inputs(seed: int = 0) -> dict:
    key = jax.random.key(seed)
    ks = jax.random.split(key, 18)
    D = D_MODEL
    n_conv = (DEPTH + 1) // 2
    n_attn = DEPTH // 2

    def nrm(k, shape):
        return jax.random.normal(k, shape, jnp.float32)

    def lin(k, shape, fan_in, gain=1.0):
        return nrm(k, shape) * (gain * fan_in ** -0.5)

    def norm_gain(k, shape):
        return 1.0 + 0.05 * nrm(k, shape)

    return {
        "x": nrm(ks[0], (BATCH, SEQ, D)),
        "c": nrm(ks[1], (BATCH, D)),
        "ctx": nrm(ks[2], (BATCH, CTX_LEN, D)),
        "c_ctx": nrm(ks[3], (D,)),
        "w_ada": lin(ks[4], (DEPTH, D, 6 * D), D, 0.5),
        "b_ada": 0.02 * nrm(ks[5], (DEPTH, 6 * D)),
        "norm_mix": norm_gain(ks[6], (DEPTH, D)),
        "norm_ffn": norm_gain(ks[7], (DEPTH, D)),
        "conv_w_in": lin(ks[8], (n_conv, D, 3 * D), D),
        "conv_w": lin(ks[9], (n_conv, CONV_WIDTH, D), CONV_WIDTH),
        "conv_w_out": lin(ks[10], (n_conv, D, D), D),
        "attn_w_qkv": lin(ks[11], (n_attn, D, 3 * D), D),
        "attn_q_norm": norm_gain(ks[12], (n_attn, HEAD_DIM)),
        "attn_k_norm": norm_gain(ks[13], (n_attn, HEAD_DIM)),
        "attn_rpb": 0.02 * nrm(ks[14], (n_attn, N_HEADS, 2 * NA_ROWS - 1, 2 * NA_COLS - 1)),
        "attn_w_out": lin(ks[15], (n_attn, D, D), D),
        "ffn_w_in": lin(ks[16], (DEPTH, D, 2 * FFN_HIDDEN), D),
        "ffn_w_out": lin(ks[17], (DEPTH, FFN_HIDDEN, D), FFN_HIDDEN),
    }


def reference(x, c, ctx, c_ctx, w_ada, b_ada, norm_mix, norm_ffn,
              conv_w_in, conv_w, conv_w_out,
              attn_w_qkv, attn_q_norm, attn_k_norm, attn_rpb, attn_w_out,
              ffn_w_in, ffn_w_out):
    for i in range(DEPTH):
        update_ctx = i < DEPTH - 1
        j = i // 2
        mod = jax.nn.silu(c) @ w_ada[i] + b_ada[i]
        mod_c = jax.nn.silu(c_ctx) @ w_ada[i] + b_ada[i]
        sh1, sc1, g1, sh2, sc2, g2 = jnp.split(mod[:, None, :], 6, axis=-1)
        sh1c, sc1c, g1c, sh2c, sc2c, g2c = jnp.split(mod_c, 6, axis=-1)

        h = _modulate(_rms_norm(x, norm_mix[i]), sh1, sc1)
        hc = _modulate(_rms_norm(ctx, norm_mix[i]), sh1c, sc1c)
        if i % 2 == 0:
            y = _short_conv_mixer(h, conv_w_in[j], conv_w[j], conv_w_out[j])
            yc = _short_conv_mixer(hc, conv_w_in[j], conv_w[j], conv_w_out[j]) if update_ctx else None
        else:
            y, yc = _neighbourhood_attention(h, hc, attn_w_qkv[j], attn_q_norm[j], attn_k_norm[j],
                                             attn_rpb[j], attn_w_out[j], update_ctx)
        x = x + g1 * y
        x = x + g2 * _swiglu(_modulate(_rms_norm(x, norm_ffn[i]), sh2, sc2), ffn_w_in[i], ffn_w_out[i])
        if update_ctx:
            ctx = ctx + g1c * yc
            ctx = ctx + g2c * _swiglu(_modulate(_rms_norm(ctx, norm_ffn[i]), sh2c, sc2c),
                                      ffn_w_in[i], ffn_w_out[i])
    return x
```

```cpp
#include <hip/hip_runtime.h>
#include <hip/hip_cooperative_groups.h>
#include <cstdio>
#include <cstdint>
namespace cg = cooperative_groups;
namespace pg8 {
#define PG8_LAS __attribute__((address_space(3)))
typedef unsigned short bf16_t;
typedef short bf16x8 __attribute__((ext_vector_type(8)));
typedef float f32x4 __attribute__((ext_vector_type(4)));
typedef unsigned u32x4 __attribute__((ext_vector_type(4)));
constexpr int BM = 256, BK = 64, HALF = 128, HTB = HALF * BK * 2  , STAGE_BYTES = 8 * HTB, NXCD = 8, WGM = 8;

__host__ __device__ __forceinline__ int lds_byte(int r, int c) { const int st = (r >> 4) * 2 + (c >> 5), rr = r & 15, cc = c & 31, ob = rr * 64 + cc * 2; return st * 1024 + (ob ^ (((ob >> 9) & 1) << 5)); }
__host__ __device__ __forceinline__ void stage_rc(int b, int& R, int& C) { const int st = b / 1024, sb = b % 1024, swz = sb ^ (((sb >> 9) & 1) << 5); R = (st >> 1) * 16 + swz / 64; C = (st & 1) * 32 + (swz % 64) / 2; }
__host__ __device__ __forceinline__ int perm32(int rho) { const int n = rho >> 4, i = rho & 15; return 8 * (i >> 2) + 4 * n + (i & 3); }

struct Unit { int pm, pn; };
struct Gemm { const bf16_t* A; const bf16_t* Bt; int M, N, K; };

struct StaticOrder {
    int nM, nN, nwg, G, c, rev;
    __host__ __device__ void init(int M, int N, int G_, int c_) { nM = M / BM; nN = N / BM; nwg = nM * nN; G = G_; c = c_; rev = 0; }
    __host__ __device__ bool next(int i, Unit& u) const {
        const long L = (long)i * G + c; if (L >= nwg) return false;
        int wgid = rev ? (int)(nwg - 1 - L) : (int)L; { const int q = nwg / NXCD, r = nwg % NXCD, xcd = wgid % NXCD, off = wgid / NXCD; wgid = (xcd < r ? xcd * (q + 1) : r * (q + 1) + (xcd - r) * q) + off; }
        const int nig = WGM * nN, gid = wgid / nig, fm = gid * WGM, gsz = (nM - fm) < WGM ? (nM - fm) : WGM;
        u.pm = fm + ((wgid % nig) % gsz); u.pn = (wgid % nig) / gsz; return true;
    }
    __device__ __forceinline__ void a_ready(const Unit&) const {}
    __device__ __forceinline__ void done(const Unit&) const {}
};

template <class Epi, class Sched, bool ALIGN_EPI = false, bool SP2 = false>
__device__ __forceinline__ void gemm_phase(PG8_LAS unsigned char* lds, const Gemm g, const Sched& S, const Epi& E) {
    int tid_ = threadIdx.x; asm volatile("" : "+v"(tid_));
    const int tid = tid_, wid = __builtin_amdgcn_readfirstlane(tid >> 6), lane = tid & 63, wr = wid >> 2, wc = wid & 3, fr = lane & 15, fq = lane >> 4;
    const int K = g.K, nt = K / BK;
    unsigned voffA[2], voffB[2];
#pragma unroll
    for (int i = 0; i < 2; ++i) { int R, C; stage_rc(tid * 16 + i * 8192, R, C); const int Rb = Epi::PERM ? ((R & ~31) + perm32(R & 31)) : R;
        voffA[i] = (unsigned)(R * K + C) * 2u; voffB[i] = (unsigned)(Rb * K + C) * 2u; }
    const size_t kstep = (size_t)(BK * 2);
    const size_t hstep = (size_t)HALF * K * 2;
    const size_t tstep = 2 * hstep;
    const unsigned ldsw = (unsigned)wid * 1024u;
    const int aoff = lds_byte(wr * 64 + fr, fq * 8), boff = lds_byte(wc * 32 + fr, fq * 8);
#define PG8_SA(b, h) (((b) * 2 + (h)) * HTB)
#define PG8_SB(b, h) ((4 + (b) * 2 + (h)) * HTB)
#define PG8_STAGE(bufoff, gbase, voff) do { _Pragma("unroll") for (int _i = 0; _i < 2; ++_i) \
        __builtin_amdgcn_global_load_lds((const unsigned*)((const char*)(gbase) + (voff)[_i]), (PG8_LAS unsigned*)(lds + (bufoff) + ldsw + _i * 8192), 16, 0, 0); } while (0)
#define PG8_LDA(dst, b, h) do { _Pragma("unroll") for (int m = 0; m < 4; ++m) _Pragma("unroll") for (int k = 0; k < 2; ++k) dst[m][k] = *(const PG8_LAS bf16x8*)(lds + PG8_SA(b, h) + aoff + m * 2048 + k * 1024); } while (0)
#define PG8_LDB(dst, b, h) do { _Pragma("unroll") for (int n = 0; n < 2; ++n) _Pragma("unroll") for (int k = 0; k < 2; ++k) dst[n][k] = *(const PG8_LAS bf16x8*)(lds + PG8_SB(b, h) + boff + n * 2048 + k * 1024); } while (0)
#define PG8_MMA(ai, bj, At, Bt) do { __builtin_amdgcn_s_setprio(1); _Pragma("unroll") for (int m = 0; m < 4; ++m) _Pragma("unroll") for (int n = 0; n < 2; ++n) _Pragma("unroll") for (int k = 0; k < 2; ++k) \
        acc[ai][bj][m][n] = __builtin_amdgcn_mfma_f32_16x16x32_bf16(Bt[n][k], At[m][k], acc[ai][bj][m][n], 0, 0, 0); __builtin_amdgcn_s_setprio(0); } while (0)
#define PG8_WAIT_V(n) asm volatile("s_waitcnt vmcnt(" #n ")" ::: "memory")
#define PG8_WAIT_L(n) asm volatile("s_waitcnt lgkmcnt(" #n ")" ::: "memory")
#define PG8_BAR __builtin_amdgcn_s_barrier()
#define PG8_SCHED __builtin_amdgcn_sched_barrier(0)
    Unit cur, nxt; int ui = 0;
    if (!S.next(0, cur)) return;
    f32x4 acc[2][2][4][2];
#pragma unroll
    for (int a = 0; a < 2; ++a)
#pragma unroll
        for (int b = 0; b < 2; ++b)
#pragma unroll
            for (int m = 0; m < 4; ++m)
#pragma unroll
                for (int n = 0; n < 2; ++n) acc[a][b][m][n] = (f32x4){0.f, 0.f, 0.f, 0.f};
    bf16x8 At[4][2], B0[2][2], B1[2][2];
    const char* cA = (const char*)g.A + (size_t)cur.pm * tstep; const char* cB = (const char*)g.Bt + (size_t)cur.pn * tstep;
    S.a_ready(cur);
    if constexpr (SP2) {
        PG8_STAGE(PG8_SB(0, 0), cB, voffB); PG8_STAGE(PG8_SB(0, 1), cB + hstep, voffB); PG8_STAGE(PG8_SA(0, 0), cA, voffA); PG8_STAGE(PG8_SA(0, 1), cA + hstep, voffA);
        if (wr == 1) PG8_BAR;
        PG8_WAIT_V(2); PG8_BAR;
        PG8_STAGE(PG8_SB(1, 0), cB + kstep, voffB); PG8_STAGE(PG8_SA(1, 0), cA + kstep, voffA); PG8_STAGE(PG8_SB(1, 1), cB + hstep + kstep, voffB);
        PG8_WAIT_V(6); PG8_BAR;
    } else {
        PG8_STAGE(PG8_SB(0, 0), cB, voffB); PG8_STAGE(PG8_SA(0, 0), cA, voffA); PG8_STAGE(PG8_SB(0, 1), cB + hstep, voffB); PG8_STAGE(PG8_SA(0, 1), cA + hstep, voffA);
        if (wr == 1) PG8_BAR;
        PG8_WAIT_V(4); PG8_BAR;
        PG8_STAGE(PG8_SB(1, 0), cB + kstep, voffB); PG8_STAGE(PG8_SA(1, 0), cA + kstep, voffA); PG8_STAGE(PG8_SB(1, 1), cB + hstep + kstep, voffB);
        PG8_WAIT_V(6); PG8_BAR;
    }
    for (;;) {
        const bool has_next = S.next(ui + 1, nxt);
        const char* nA = has_next ? (const char*)g.A + (size_t)nxt.pm * tstep : cA; const char* nB = has_next ? (const char*)g.Bt + (size_t)nxt.pn * tstep : cB;
        for (int t = 0; t < nt; t += 2) {
            const bool last = (t == nt - 2);
            const char* a1 = cA + (size_t)(t + 1) * kstep;
            const char* a2 = last ? nA : cA + (size_t)(t + 2) * kstep; const char* b2 = last ? nB : cB + (size_t)(t + 2) * kstep;
            const char* a3 = a2 + kstep; const char* b3 = b2 + kstep;
            if (last && has_next) S.a_ready(nxt);
            if constexpr (SP2) {
            PG8_LDB(B0, 0, 0); PG8_LDB(B1, 0, 1); PG8_SCHED; PG8_LDA(At, 0, 0); PG8_STAGE(PG8_SA(1, 1), a1 + hstep, voffA);
            PG8_WAIT_V(8); PG8_WAIT_L(0); PG8_BAR; PG8_MMA(0, 0, At, B0); PG8_MMA(0, 1, At, B1); PG8_BAR; PG8_SCHED;
            PG8_LDA(At, 0, 1); PG8_STAGE(PG8_SB(0, 0), b2, voffB); PG8_STAGE(PG8_SB(0, 1), b2 + hstep, voffB); PG8_STAGE(PG8_SA(0, 0), a2, voffA);
            PG8_WAIT_V(8); PG8_WAIT_L(0); PG8_BAR; PG8_MMA(1, 0, At, B0); PG8_MMA(1, 1, At, B1); PG8_BAR; PG8_SCHED;
            PG8_LDB(B0, 1, 0); PG8_LDB(B1, 1, 1); PG8_SCHED; PG8_LDA(At, 1, 0); PG8_STAGE(PG8_SA(0, 1), a2 + hstep, voffA);
            PG8_WAIT_V(8); PG8_WAIT_L(0); PG8_BAR; PG8_MMA(0, 0, At, B0); PG8_MMA(0, 1, At, B1); PG8_BAR; PG8_SCHED;
            PG8_LDA(At, 1, 1); PG8_STAGE(PG8_SB(1, 0), b3, voffB); PG8_STAGE(PG8_SB(1, 1), b3 + hstep, voffB); PG8_STAGE(PG8_SA(1, 0), a3, voffA);
            PG8_WAIT_V(8); PG8_WAIT_L(0); PG8_BAR; PG8_MMA(1, 0, At, B0); PG8_MMA(1, 1, At, B1); PG8_BAR; PG8_SCHED;
            } else {
            PG8_LDB(B0, 0, 0); PG8_SCHED; PG8_LDA(At, 0, 0); PG8_STAGE(PG8_SA(1, 1), a1 + hstep, voffA);
            PG8_WAIT_L(8); PG8_BAR; PG8_WAIT_L(0); PG8_MMA(0, 0, At, B0); PG8_BAR; PG8_SCHED;
            PG8_LDB(B1, 0, 1); PG8_STAGE(PG8_SB(0, 0), b2, voffB);
            PG8_BAR; PG8_WAIT_L(0); PG8_MMA(0, 1, At, B1); PG8_BAR;
            PG8_LDA(At, 0, 1); PG8_STAGE(PG8_SA(0, 0), a2, voffA);
            PG8_BAR; PG8_WAIT_L(0); PG8_MMA(1, 0, At, B0); PG8_BAR; PG8_SCHED;
            PG8_STAGE(PG8_SB(0, 1), b2 + hstep, voffB);
            PG8_WAIT_V(6); PG8_BAR; PG8_MMA(1, 1, At, B1); PG8_BAR;
            PG8_LDB(B0, 1, 0); PG8_SCHED; PG8_LDA(At, 1, 0); PG8_STAGE(PG8_SA(0, 1), a2 + hstep, voffA);
            PG8_WAIT_L(8); PG8_BAR; PG8_WAIT_L(0); PG8_MMA(0, 0, At, B0); PG8_BAR; PG8_SCHED;
            PG8_LDB(B1, 1, 1); PG8_STAGE(PG8_SB(1, 0), b3, voffB);
            PG8_BAR; PG8_WAIT_L(0); PG8_MMA(0, 1, At, B1); PG8_BAR;
            PG8_LDA(At, 1, 1); PG8_STAGE(PG8_SA(1, 0), a3, voffA);
            PG8_BAR; PG8_WAIT_L(0); PG8_MMA(1, 0, At, B0); PG8_BAR; PG8_SCHED;
            PG8_STAGE(PG8_SB(1, 1), b3 + hstep, voffB);
            PG8_WAIT_V(6); PG8_BAR; PG8_MMA(1, 1, At, B1); PG8_BAR;
            }
        }
        if constexpr (ALIGN_EPI) { if (wr == 0) PG8_BAR; }
        if constexpr (!Epi::AFTER_DRAIN) { E(acc, cur, wr, wc, fr, fq); S.done(cur); }
        if (!has_next) break;
#pragma unroll
        for (int a = 0; a < 2; ++a)
#pragma unroll
            for (int b = 0; b < 2; ++b)
#pragma unroll
                for (int m = 0; m < 4; ++m)
#pragma unroll
                    for (int n = 0; n < 2; ++n) acc[a][b][m][n] = (f32x4){0.f, 0.f, 0.f, 0.f};
        cur = nxt; cA = nA; cB = nB; ++ui;
        if constexpr (ALIGN_EPI) { if (wr == 1) PG8_BAR; }
    }
    PG8_WAIT_V(0);
    if constexpr (!ALIGN_EPI) { if (wr == 0) PG8_BAR; }
    PG8_BAR;
    if constexpr (Epi::AFTER_DRAIN) { E.fused(acc, cur, wr, wc, fr, fq, lds, wid, lane); S.done(cur); }
#undef PG8_SA
#undef PG8_SB
#undef PG8_STAGE
#undef PG8_LDA
#undef PG8_LDB
#undef PG8_MMA
#undef PG8_WAIT_V
#undef PG8_WAIT_L
#undef PG8_BAR
#undef PG8_SCHED
}
}

#define LAS __attribute__((address_space(3)))
using pg8::bf16_t; using pg8::bf16x8; using pg8::f32x4; using pg8::u32x4; using pg8::Unit;
typedef unsigned u32x2 __attribute__((ext_vector_type(2)));
typedef float f32x2 __attribute__((ext_vector_type(2)));
typedef float f32x16 __attribute__((ext_vector_type(16)));
typedef __bf16 bf16v2 __attribute__((ext_vector_type(2)));

constexpr int D = 1024, NB = 8, SEQ = 8192, DEPTH = 4, CTX = 256, NH = 16, HD = 64, FF = 2816, GW = 64;
constexpr int ML = NB * SEQ, MC = NB * CTX, MA = ML + MC;
constexpr int NS = 9;
constexpr float EPS = 1e-6f;
constexpr int NTHR = 512, NWAVE = 8;
constexpr int LDS_BYTES = 147456;

constexpr size_t MiB = 1u << 20;
constexpr size_t WS_MOD = 0;
constexpr size_t WS_SWM = 1 * MiB;
constexpr size_t WS_SWF = 2 * MiB;
constexpr size_t WS_RSS = 3 * MiB;
constexpr size_t WS_XC = 6 * MiB;
constexpr size_t WS_BAR = 15 * MiB, BAR_BYTES = 16384;
#ifdef PROBE_RES2
constexpr size_t WS_ZERO = 15 * MiB + 65536, ZERO_BYTES = 262144;
#endif
constexpr size_t WS_WT = 16 * MiB;
constexpr size_t WT_MIXIN = 0, WT_MIXOUT = (size_t)3072 * 1024 * 2, WT_FFNIN = WT_MIXOUT + (size_t)1024 * 1024 * 2, WT_FFNOUT = WT_FFNIN + (size_t)5632 * 1024 * 2, WT_LAYER = WT_FFNOUT + (size_t)1024 * 2816 * 2;
constexpr size_t WS_XS = 128 * MiB;
constexpr size_t ACT = (size_t)MA * D * 2;
constexpr size_t WS_A0 = 264 * MiB;
constexpr size_t WS_A1 = WS_A0 + ACT;
constexpr size_t WS_A2 = WS_A1 + ACT;
constexpr size_t WS_A3 = WS_A2 + ACT;
constexpr size_t WS_G = WS_A0;
constexpr size_t WS_END = WS_A3 + ACT;
static_assert(WS_WT + 4 * WT_LAYER <= WS_XS && WS_XS + ACT <= WS_A0 && (size_t)MA * FF * 2 <= 3 * ACT, "d_ws map");

__device__ __forceinline__ unsigned pk2(float a, float b) { f32x2 v = {a, b}; return __builtin_bit_cast(unsigned, __builtin_convertvector(v, bf16v2)); }
__device__ __forceinline__ float bflo(unsigned u) { return __uint_as_float(u << 16); }
__device__ __forceinline__ float bfhi(unsigned u) { return __uint_as_float(u & 0xffff0000u); }
__device__ __forceinline__ float wave_sum(float v) {
#pragma unroll
    for (int o = 1; o < 64; o <<= 1) v += __shfl_xor(v, o);
    return v;
}
#define LDS_WAIT() asm volatile("s_waitcnt lgkmcnt(0)" ::: "memory")


struct EpiRes {
    static constexpr bool PERM = false, AFTER_DRAIN = false;
    const float* xin_l; const float* xin_c; float* xout_l; float* xout_c;
    const float* gate;
    const float* nrm;
    const float* nsc;
    bf16_t* xs; float* rss;
    __device__ __forceinline__ void operator()(const f32x4 (&acc)[2][2][4][2], const Unit& u, int wr, int wc, int fr, int fq) const {
        const bool lat = u.pm < 256; const int s = lat ? (u.pm >> 5) : 8;
        const size_t toff = (size_t)(lat ? u.pm : u.pm - 256) * 256 * D;
        const float* xi = (lat ? xin_l : xin_c) + toff; float* xo = (lat ? xout_l : xout_c) + toff;
        bf16_t* xsb = xs + (size_t)u.pm * 256 * D; float* rsb = rss + u.pm * 256;
        const float* gt = gate + s * 6144 + u.pn * 256; const float* nsp = nsc + s * 6144 + u.pn * 256; const float* nrp = nrm + u.pn * 256;
        const unsigned cl = wc * 32 + 4 * fq;
        const unsigned voff = (unsigned)(wr * 64 + fr) * D + u.pn * 256 + cl;
        float ss[2][4];
#pragma unroll
        for (int ai = 0; ai < 2; ++ai)
#pragma unroll
            for (int m = 0; m < 4; ++m) ss[ai][m] = 0.f;
#pragma unroll
        for (int bj = 0; bj < 2; ++bj)
#pragma unroll
            for (int n = 0; n < 2; ++n) { const int co = bj * 128 + n * 16;
                f32x4 xv[2][4];
                const f32x4 gv = *(const f32x4*)(gt + co + cl);
                f32x4 nv = (f32x4){0.f, 0.f, 0.f, 0.f}; if (nrm) nv = *(const f32x4*)(nrp + co + cl) * (*(const f32x4*)(nsp + co + cl) + 1.0f);
#pragma unroll
                for (int ai = 0; ai < 2; ++ai)
#pragma unroll
                    for (int m = 0; m < 4; ++m) xv[ai][m] = *(const f32x4*)(xi + (size_t)(ai * 128 + m * 16) * D + co + voff);
                asm volatile("" ::: "memory");
#pragma unroll
                for (int ai = 0; ai < 2; ++ai)
#pragma unroll
                    for (int m = 0; m < 4; ++m) { const size_t rb = (size_t)(ai * 128 + m * 16) * D + co;
                        const f32x4 x2 = xv[ai][m] + gv * acc[ai][bj][m][n]; *(f32x4*)(xo + rb + voff) = x2;
                        if (nrm) { ss[ai][m] += (x2[0] * x2[0] + x2[1] * x2[1]) + (x2[2] * x2[2] + x2[3] * x2[3]); const f32x4 y = x2 * nv; u32x2 w; w.x = pk2(y[0], y[1]); w.y = pk2(y[2], y[3]);
                            *(u32x2*)(xsb + rb + voff) = w; } }
                asm volatile("" ::: "memory");
            }
        if (nrm) {
#pragma unroll
            for (int ai = 0; ai < 2; ++ai)
#pragma unroll
                for (int m = 0; m < 4; ++m) { float t = ss[ai][m]; t += __shfl_xor(t, 16); t += __shfl_xor(t, 32); if (fq == 0) unsafeAtomicAdd(rsb + (ai * 128 + m * 16) + (wr * 64 + fr), t); } }
    }
};
struct EpiConvIn {
    static constexpr bool PERM = false, AFTER_DRAIN = false;
    const float* rss; const float* sW;
    bf16_t* BB; bf16_t* ZZ;
    __device__ __forceinline__ void operator()(const f32x4 (&acc)[2][2][4][2], const Unit& u, int wr, int wc, int fr, int fq) const {
        const int s = u.pm < 256 ? (u.pm >> 5) : 8; const float* sw = sW + s * 3072; const float* rsb = rss + u.pm * 256;
        const unsigned rl = wr * 64 + fr, cl = wc * 32 + 8 * fq;
        if (u.pn < 4) {
            asm volatile("" ::: "memory");
            const float* swb = sw + u.pn * 256; bf16_t* ob = BB + (size_t)u.pm * 256 * D + u.pn * 256; const unsigned voff = rl * D + cl;
            f32x4 sv[2][2];
#pragma unroll
            for (int bj = 0; bj < 2; ++bj)
#pragma unroll
                for (int n = 0; n < 2; ++n) sv[bj][n] = *(const f32x4*)(swb + bj * 128 + 4 * n + cl);
#pragma unroll
            for (int ai = 0; ai < 2; ++ai) { float rs4[4];
#pragma unroll
                for (int m = 0; m < 4; ++m) rs4[m] = rsqrtf(*(rsb + (ai * 128 + m * 16) + rl) * (1.0f / D) + EPS);
                asm volatile("" ::: "memory");
#pragma unroll
                for (int m = 0; m < 4; ++m) { const float rstd = rs4[m];
#pragma unroll
                    for (int bj = 0; bj < 2; ++bj) { const f32x4 v0 = acc[ai][bj][m][0] * rstd + sv[bj][0], v1 = acc[ai][bj][m][1] * rstd + sv[bj][1];
                        u32x4 w; w.x = pk2(v0[0], v0[1]); w.y = pk2(v0[2], v0[3]); w.z = pk2(v1[0], v1[1]); w.w = pk2(v1[2], v1[3]);
                        *(u32x4*)(ob + (size_t)(ai * 128 + m * 16) * D + bj * 128 + voff) = w; }
                    asm volatile("" ::: "memory"); } }
        } else {
            asm volatile("" ::: "memory");
            const float* swb = sw + (u.pn - 4) * 128; bf16_t* ob = ZZ + (size_t)u.pm * 256 * D + (u.pn - 4) * 128; const unsigned voff = rl * D + cl;
            f32x4 sc[2], su[2];
#pragma unroll
            for (int n = 0; n < 2; ++n) { sc[n] = *(const f32x4*)(swb + 1024 + 4 * n + cl); su[n] = *(const f32x4*)(swb + 2048 + 4 * n + cl); }
#pragma unroll
            for (int ai = 0; ai < 2; ++ai) { float rs4[4];
#pragma unroll
                for (int m = 0; m < 4; ++m) rs4[m] = rsqrtf(*(rsb + (ai * 128 + m * 16) + rl) * (1.0f / D) + EPS);
                asm volatile("" ::: "memory");
#pragma unroll
                for (int m = 0; m < 4; ++m) { const float rstd = rs4[m];
                    const f32x4 z0 = (acc[ai][0][m][0] * rstd + sc[0]) * (acc[ai][1][m][0] * rstd + su[0]), z1 = (acc[ai][0][m][1] * rstd + sc[1]) * (acc[ai][1][m][1] * rstd + su[1]);
                    u32x4 w; w.x = pk2(z0[0], z0[1]); w.y = pk2(z0[2], z0[3]); w.z = pk2(z1[0], z1[1]); w.w = pk2(z1[2], z1[3]);
                    *(u32x4*)(ob + (size_t)(ai * 128 + m * 16) * D + voff) = w;
                    asm volatile("" ::: "memory"); } }
        }
    }
};
struct EpiQKV {
    static constexpr bool PERM = false, AFTER_DRAIN = false;
    const float* rss; const float* sW; const float* gq; const float* gk; bf16_t* QKV;
    __device__ __forceinline__ void operator()(const f32x4 (&acc)[2][2][4][2], const Unit& u, int wr, int wc, int fr, int fq) const {
        const int s = u.pm < 256 ? (u.pm >> 5) : 8; const float* rsb = rss + u.pm * 256;
        const int part = u.pn >> 2, head = 4 * (u.pn & 3) + wc;
        const float* sw = sW + s * 3072 + 1024 * part + 64 * head;
        const float* gp = (part == 0 ? gq : gk); const float gs = part == 0 ? 0.125f * 1.4426950408889634f : 1.0f;
        bf16_t* ob = QKV + (size_t)part * (ACT / 2) + (size_t)u.pm * 256 * D + 64 * head;
        const unsigned rl = wr * 64 + fr, voff = rl * D + 8 * fq;
        float rstdv[2][4];
#pragma unroll
        for (int ai = 0; ai < 2; ++ai)
#pragma unroll
            for (int m = 0; m < 4; ++m) rstdv[ai][m] = rsqrtf(*(rsb + (ai * 128 + m * 16) + rl) * (1.0f / D) + EPS);
        asm volatile("" ::: "memory");
        f32x4 sv[2][2], gv[2][2];
#pragma unroll
        for (int bj = 0; bj < 2; ++bj)
#pragma unroll
            for (int n = 0; n < 2; ++n) { sv[bj][n] = *(const f32x4*)(sw + 32 * bj + 4 * n + 8 * fq); gv[bj][n] = *(const f32x4*)(gp + 32 * bj + 4 * n + 8 * fq) * gs; }
#pragma unroll
        for (int ai = 0; ai < 2; ++ai)
#pragma unroll
            for (int m = 0; m < 4; ++m) { const float rstd = rstdv[ai][m];
                f32x4 v00 = acc[ai][0][m][0] * rstd + sv[0][0], v01 = acc[ai][0][m][1] * rstd + sv[0][1], v10 = acc[ai][1][m][0] * rstd + sv[1][0], v11 = acc[ai][1][m][1] * rstd + sv[1][1];
                if (part < 2) { float ss = ((v00[0] * v00[0] + v00[1] * v00[1]) + (v00[2] * v00[2] + v00[3] * v00[3])) + ((v01[0] * v01[0] + v01[1] * v01[1]) + (v01[2] * v01[2] + v01[3] * v01[3]))
                                         + ((v10[0] * v10[0] + v10[1] * v10[1]) + (v10[2] * v10[2] + v10[3] * v10[3])) + ((v11[0] * v11[0] + v11[1] * v11[1]) + (v11[2] * v11[2] + v11[3] * v11[3]));
                    ss += __shfl_xor(ss, 16); ss += __shfl_xor(ss, 32); const float r = rsqrtf(ss * (1.0f / HD) + EPS);
                    v00 = v00 * r * gv[0][0]; v01 = v01 * r * gv[0][1]; v10 = v10 * r * gv[1][0]; v11 = v11 * r * gv[1][1]; }
                bf16_t* orow = ob + (size_t)(ai * 128 + m * 16) * D;
                { u32x4 w; w.x = pk2(v00[0], v00[1]); w.y = pk2(v00[2], v00[3]); w.z = pk2(v01[0], v01[1]); w.w = pk2(v01[2], v01[3]); *(u32x4*)(orow + voff) = w; }
                { u32x4 w; w.x = pk2(v10[0], v10[1]); w.y = pk2(v10[2], v10[3]); w.z = pk2(v11[0], v11[1]); w.w = pk2(v11[2], v11[3]); *(u32x4*)(orow + 32 + voff) = w; } }
    }
};
struct EpiSwi {
    static constexpr bool PERM = false, AFTER_DRAIN = false;
    const float* rss; const float* sW;
    bf16_t* G;
    __device__ __forceinline__ void operator()(const f32x4 (&acc)[2][2][4][2], const Unit& u, int wr, int wc, int fr, int fq) const {
        const int s = u.pm < 256 ? (u.pm >> 5) : 8; const float* swb = sW + s * (2 * FF) + u.pn * 128; const float* rsb = rss + u.pm * 256;
        bf16_t* ob = G + (size_t)u.pm * 256 * FF + u.pn * 128;
        const unsigned rl = wr * 64 + fr, cl = wc * 32 + 8 * fq, voff = rl * FF + cl;
        float rstdv[2][4];
#pragma unroll
        for (int ai = 0; ai < 2; ++ai)
#pragma unroll
            for (int m = 0; m < 4; ++m) rstdv[ai][m] = rsqrtf(*(rsb + (ai * 128 + m * 16) + rl) * (1.0f / D) + EPS);
        asm volatile("" ::: "memory");
        f32x4 sg[2], su[2];
#pragma unroll
        for (int n = 0; n < 2; ++n) { sg[n] = *(const f32x4*)(swb + 4 * n + cl); su[n] = *(const f32x4*)(swb + FF + 4 * n + cl); }
#pragma unroll
        for (int ai = 0; ai < 2; ++ai)
#pragma unroll
            for (int m = 0; m < 4; ++m) { const float rstd = rstdv[ai][m];
                f32x4 o[2];
#pragma unroll
                for (int n = 0; n < 2; ++n) { const f32x4 g = acc[ai][0][m][n] * rstd + sg[n], up = acc[ai][1][m][n] * rstd + su[n];
#pragma unroll
                    for (int e = 0; e < 4; ++e) o[n][e] = g[e] * __builtin_amdgcn_rcpf(1.0f + __builtin_amdgcn_exp2f(g[e] * -1.4426950408889634f)) * up[e]; }
                u32x4 w; w.x = pk2(o[0][0], o[0][1]); w.y = pk2(o[0][2], o[0][3]); w.z = pk2(o[1][0], o[1][1]); w.w = pk2(o[1][2], o[1][3]);
                *(u32x4*)(ob + (size_t)(ai * 128 + m * 16) * FF + voff) = w; }
    }
};

__device__ __forceinline__ void gemv9_task(LAS float* vl, LAS float* red, const float* W, int ldw, int col0, float* out, int ostride, const float* bias) {
    const int tid = threadIdx.x, lane = tid & 63, w = tid >> 6;
    float a[NS][2];
#pragma unroll
    for (int s = 0; s < NS; ++s) { a[s][0] = 0.f; a[s][1] = 0.f; }
    const float* wp = W + (size_t)(128 * w) * ldw + col0 + 2 * lane;
#pragma unroll 8
    for (int kk = 0; kk < 128; ++kk) {
        const f32x2 wv = *(const f32x2*)(wp + (size_t)kk * ldw);
        const LAS f32x4* v = (const LAS f32x4*)(vl + (128 * w + kk) * 12);
        const f32x4 v0 = v[0], v1 = v[1], v2 = v[2];
        a[0][0] += v0[0] * wv[0]; a[0][1] += v0[0] * wv[1]; a[1][0] += v0[1] * wv[0]; a[1][1] += v0[1] * wv[1];
        a[2][0] += v0[2] * wv[0]; a[2][1] += v0[2] * wv[1]; a[3][0] += v0[3] * wv[0]; a[3][1] += v0[3] * wv[1];
        a[4][0] += v1[0] * wv[0]; a[4][1] += v1[0] * wv[1]; a[5][0] += v1[1] * wv[0]; a[5][1] += v1[1] * wv[1];
        a[6][0] += v1[2] * wv[0]; a[6][1] += v1[2] * wv[1]; a[7][0] += v1[3] * wv[0]; a[7][1] += v1[3] * wv[1];
        a[8][0] += v2[0] * wv[0]; a[8][1] += v2[0] * wv[1];
    }
#pragma unroll
    for (int s = 0; s < NS; ++s) { red[(w * NS + s) * 128 + 2 * lane] = a[s][0]; red[(w * NS + s) * 128 + 2 * lane + 1] = a[s][1]; }
    __syncthreads();
    for (int idx = tid; idx < NS * 128; idx += NTHR) { const int s = idx >> 7, c = idx & 127; float t = bias ? bias[col0 + c] : 0.f;
#pragma unroll
        for (int ww = 0; ww < NWAVE; ++ww) t += red[(ww * NS + s) * 128 + c];
        out[(size_t)s * ostride + col0 + c] = t; }
    __syncthreads();
}

__device__ __forceinline__ void transpose_item(const float* W, int K, int N, bf16_t* WT, int src0, int nrow0, bool perm, int k0, LAS float* scr, int lane) {
#pragma unroll
    for (int i = 0; i < 32; ++i) { const int kk = 2 * i + (lane >> 5); scr[kk * 33 + (lane & 31)] = W[(size_t)(k0 + kk) * N + src0 + (lane & 31)]; }
    LDS_WAIT(); asm volatile("" ::: "memory");
    const int c = lane & 7;
#pragma unroll
    for (int j = 0; j < 4; ++j) { const int nl = (lane >> 3) + 8 * j; const int pc = perm ? pg8::perm32(nl) : nl; const LAS float* s = scr + (8 * c) * 33 + pc;
        u32x4 o; o.x = pk2(s[0 * 33], s[1 * 33]); o.y = pk2(s[2 * 33], s[3 * 33]); o.z = pk2(s[4 * 33], s[5 * 33]); o.w = pk2(s[6 * 33], s[7 * 33]);
        *(u32x4*)(WT + (size_t)(nrow0 + nl) * K + k0 + 8 * c) = o; }
    LDS_WAIT(); asm volatile("" ::: "memory");
}

struct Params { const float* in[18]; float* out; unsigned char* ws; };
enum { I_X = 0, I_C, I_CTX, I_CCTX, I_WADA, I_BADA, I_NMIX, I_NFFN, I_CWIN, I_CW, I_CWOUT, I_AQKV, I_AQN, I_AKN, I_ARPB, I_AWOUT, I_FWIN, I_FWOUT };

__device__ __forceinline__ void conv_phase(const bf16_t* BB, const bf16_t* ZZ, bf16_t* A3, const float* cw, int gw_, int ngw, int lane_) {
    int lane = lane_, gw = gw_; asm volatile("" : "+v"(lane), "+s"(gw));
    constexpr int CH = 33; constexpr int NT = MA / CH; static_assert(NT * CH == MA, "conv chunks");
    f32x4 w0[4], w1[4], w2[4];
#pragma unroll
    for (int q = 0; q < 4; ++q) { w0[q] = *(const f32x4*)(cw + 16 * lane + 4 * q); w1[q] = *(const f32x4*)(cw + D + 16 * lane + 4 * q); w2[q] = *(const f32x4*)(cw + 2 * D + 16 * lane + 4 * q); }
    for (int task = gw; task < NT; task += ngw) {
        const int g0 = task * CH;
        const u32x4 zero = {0u, 0u, 0u, 0u};
        u32x4 zp[2], zc[2], nz[3][2], nb[3][2];
        { const u32x4* p = (const u32x4*)(ZZ + (size_t)g0 * D + 16 * lane); zc[0] = p[0]; zc[1] = p[1]; }
        if (g0 > 0) { const u32x4* p = (const u32x4*)(ZZ + (size_t)(g0 - 1) * D + 16 * lane); zp[0] = p[0]; zp[1] = p[1]; } else { zp[0] = zero; zp[1] = zero; }
#pragma unroll
        for (int k = 0; k < 3; ++k) { const int g = g0 + k;
            if (g + 1 < MA) { const u32x4* p = (const u32x4*)(ZZ + (size_t)(g + 1) * D + 16 * lane); nz[k][0] = p[0]; nz[k][1] = p[1]; } else { nz[k][0] = zero; nz[k][1] = zero; }
            { const u32x4* p = (const u32x4*)(BB + (size_t)g * D + 16 * lane); nb[k][0] = p[0]; nb[k][1] = p[1]; } }
        for (int grp = 0; grp < CH / 3; ++grp) {
            u32x4 pz[3][2], pb[3][2];
#pragma unroll
            for (int k = 0; k < 3; ++k) { const int g = g0 + 3 * (grp + 1) + k;
                if (grp + 1 < CH / 3) {
                    if (g + 1 < MA) { const u32x4* p = (const u32x4*)(ZZ + (size_t)(g + 1) * D + 16 * lane); pz[k][0] = p[0]; pz[k][1] = p[1]; } else { pz[k][0] = zero; pz[k][1] = zero; }
                    { const u32x4* p = (const u32x4*)(BB + (size_t)g * D + 16 * lane); pb[k][0] = p[0]; pb[k][1] = p[1]; } }
                else { pz[k][0] = zero; pz[k][1] = zero; pb[k][0] = zero; pb[k][1] = zero; } }
#pragma unroll
            for (int k = 0; k < 3; ++k) {
                const int g = g0 + 3 * grp + k;
                const int pos = g < ML ? (g & (SEQ - 1)) : ((g - ML) & (CTX - 1)); const int L = g < ML ? SEQ : CTX;
                const float mp = pos > 0 ? 1.f : 0.f, mn = pos < L - 1 ? 1.f : 0.f;
                u32x4 ov[2];
#pragma unroll
                for (int hh = 0; hh < 2; ++hh)
#pragma unroll
                    for (int q = 0; q < 4; ++q) { const int wq = hh * 2 + (q >> 1), e0 = (q & 1) * 2;
                        const float lo = bflo(nb[k][hh][q]) * (w0[wq][e0] * mp * bflo(zp[hh][q]) + w1[wq][e0] * bflo(zc[hh][q]) + w2[wq][e0] * mn * bflo(nz[k][hh][q]));
                        const float hi = bfhi(nb[k][hh][q]) * (w0[wq][e0 + 1] * mp * bfhi(zp[hh][q]) + w1[wq][e0 + 1] * bfhi(zc[hh][q]) + w2[wq][e0 + 1] * mn * bfhi(nz[k][hh][q]));
                        ov[hh][q] = pk2(lo, hi); }
                { u32x4* p = (u32x4*)(A3 + (size_t)g * D + 16 * lane); p[0] = ov[0]; p[1] = ov[1]; }
                zp[0] = zc[0]; zp[1] = zc[1]; zc[0] = nz[k][0]; zc[1] = nz[k][1];
            }
#pragma unroll
            for (int k = 0; k < 3; ++k) { nz[k][0] = pz[k][0]; nz[k][1] = pz[k][1]; nb[k][0] = pb[k][0]; nb[k][1] = pb[k][1]; }
        }
    }
}

constexpr int KT_SZ = 64 * 144, VT_PITCH = 192, VT_SZ = 64 * VT_PITCH, AT_KT = 0, AT_VT = 2 * KT_SZ, AT_RPB = AT_VT + 2 * VT_SZ;
constexpr float LOG2E = 1.4426950408889634f;
__device__ __forceinline__ int rstart(int r) { return min(max(r - 4, 0), SEQ / GW - 8); }
#define MFMA32(a, b, c) __builtin_amdgcn_mfma_f32_32x32x16_bf16((a), (b), (c), 0, 0, 0)
typedef short s16x4 __attribute__((ext_vector_type(4)));
__device__ __forceinline__ bf16x8 vt_frag(const LAS unsigned char* vlane, int off) {
    const s16x4 lo = __builtin_amdgcn_ds_read_tr16_b64_v4i16((LAS s16x4*)(vlane + off)), hi2 = __builtin_amdgcn_ds_read_tr16_b64_v4i16((LAS s16x4*)(vlane + off + 8 * VT_PITCH));
    return __builtin_shufflevector(lo, hi2, 0, 1, 2, 3, 4, 5, 6, 7);
}
__device__ __forceinline__ const LAS unsigned char* vt_lane(const LAS unsigned char* vt, int l31, int hi) { return vt + (4 * hi + ((l31 >> 2) & 3)) * VT_PITCH + (16 * ((l31 >> 4) & 1) + 4 * (l31 & 3)) * 2; }
template <int MODE>
__device__ __forceinline__ void attn_tile(const LAS unsigned char* kt, const LAS unsigned char* vt, const LAS float* rpl, int wcs, const bf16x8 (&qf)[4], int l31, int hi, f32x16& o0, f32x16& o1, f32x16& lacc) {
    bf16x8 kf[2][4];
#pragma unroll
    for (int kb2 = 0; kb2 < 2; ++kb2)
#pragma unroll
        for (int s = 0; s < 4; ++s) kf[kb2][s] = *(const LAS bf16x8*)(kt + (32 * kb2 + l31) * 144 + (16 * s + 8 * hi) * 2);
    float bias[2][16];
#pragma unroll
    for (int kb2 = 0; kb2 < 2; ++kb2)
#pragma unroll
        for (int i = 0; i < 16; ++i) { const bool live = MODE != 0 && (MODE == 1 ? (kb2 == 0 || i < 4) : (kb2 == 1 || i >= 12)); bias[kb2][i] = live ? rpl[32 * kb2 + (i & 3) + 8 * (i >> 2)] : 0.f; }
    __builtin_amdgcn_sched_barrier(0);
    f32x16 st[2];
#pragma unroll
    for (int kb2 = 0; kb2 < 2; ++kb2) {
#pragma unroll
        for (int i = 0; i < 16; ++i) st[kb2][i] = 0.f;
    }
    __builtin_amdgcn_s_setprio(1);
#pragma unroll
    for (int s = 0; s < 4; ++s) { st[0] = MFMA32(kf[0][s], qf[s], st[0]); st[1] = MFMA32(kf[1][s], qf[s], st[1]); }
    __builtin_amdgcn_s_setprio(0);
    const LAS unsigned char* vl = vt_lane(vt, l31, hi);
    bf16x8 vf0[2][2], vf1[2][2];
#pragma unroll
    for (int kb2 = 0; kb2 < 2; ++kb2)
#pragma unroll
        for (int t = 0; t < 2; ++t) { const bool livestep = MODE == 0 || (MODE == 1 ? !(kb2 == 1 && t == 1) : !(kb2 == 0 && t == 0));
            if (livestep) { const int ko = (32 * kb2 + 16 * t) * VT_PITCH; vf0[kb2][t] = vt_frag(vl, ko); vf1[kb2][t] = vt_frag(vl, ko + 64); }
            else { vf0[kb2][t] = kf[0][0]; vf1[kb2][t] = kf[0][0]; } }
    __builtin_amdgcn_sched_barrier(0);
#pragma unroll
    for (int kb2 = 0; kb2 < 2; ++kb2)
#pragma unroll
        for (int i = 0; i < 16; ++i) {
            const int kcc = 32 * kb2 + (i & 3) + 8 * (i >> 2);
            const bool live = MODE == 0 || (MODE == 1 ? (kb2 == 0 || i < 4) : (kb2 == 1 || i >= 12));
            if (!live) { st[kb2][i] = 0.f; continue; }
            if (MODE == 0) st[kb2][i] = __builtin_amdgcn_exp2f(st[kb2][i]);
            else { const bool valid = (unsigned)(kcc - wcs) < 16u; const float pe = __builtin_amdgcn_exp2f(st[kb2][i] + bias[kb2][i]); st[kb2][i] = valid ? pe : 0.f; }
        }
    u32x4 onesw; onesw.x = 0x3f803f80u; onesw.y = 0x3f803f80u; onesw.z = 0x3f803f80u; onesw.w = 0x3f803f80u;
    const bf16x8 ones = __builtin_bit_cast(bf16x8, onesw);
#pragma unroll
    for (int kb2 = 0; kb2 < 2; ++kb2)
#pragma unroll
        for (int t = 0; t < 2; ++t) {
            const bool livestep = MODE == 0 || (MODE == 1 ? !(kb2 == 1 && t == 1) : !(kb2 == 0 && t == 0));
            if (!livestep) continue;
            u32x4 pw; pw.x = pk2(st[kb2][8 * t + 0], st[kb2][8 * t + 1]); pw.y = pk2(st[kb2][8 * t + 2], st[kb2][8 * t + 3]); pw.z = pk2(st[kb2][8 * t + 4], st[kb2][8 * t + 5]); pw.w = pk2(st[kb2][8 * t + 6], st[kb2][8 * t + 7]);
            const bf16x8 pf = __builtin_bit_cast(bf16x8, pw);
            __builtin_amdgcn_s_setprio(1);
            o0 = MFMA32(vf0[kb2][t], pf, o0);
            o1 = MFMA32(vf1[kb2][t], pf, o1);
            lacc = MFMA32(ones, pf, lacc);
            __builtin_amdgcn_s_setprio(0);
        }
}
__device__ __forceinline__ void attn_wtile(const LAS unsigned char* kt, const LAS unsigned char* vt, const LAS float* rpl, int wcsr, int kb0, const bf16x8 (&qf)[4], int l31, int hi, f32x16& o0, f32x16& o1, f32x16& lacc) {
    bf16x8 kf[4];
#pragma unroll
    for (int s = 0; s < 4; ++s) kf[s] = *(const LAS bf16x8*)(kt + (kb0 + l31) * 144 + (16 * s + 8 * hi) * 2);
    float bias[16];
#pragma unroll
    for (int i = 0; i < 16; ++i) bias[i] = rpl[(i & 3) + 8 * (i >> 2)];
    __builtin_amdgcn_sched_barrier(0);
    f32x16 st;
#pragma unroll
    for (int i = 0; i < 16; ++i) st[i] = 0.f;
    __builtin_amdgcn_s_setprio(1);
#pragma unroll
    for (int s = 0; s < 4; ++s) st = MFMA32(kf[s], qf[s], st);
    __builtin_amdgcn_s_setprio(0);
    bf16x8 vf0[2], vf1[2];
    const LAS unsigned char* vl = vt_lane(vt, l31, hi);
#pragma unroll
    for (int t = 0; t < 2; ++t) { const int ko = (kb0 + 16 * t) * VT_PITCH; vf0[t] = vt_frag(vl, ko); vf1[t] = vt_frag(vl, ko + 64); }
    __builtin_amdgcn_sched_barrier(0);
#pragma unroll
    for (int i = 0; i < 16; ++i) { const int kcc = (i & 3) + 8 * (i >> 2); const bool valid = (unsigned)(kcc - wcsr) < 16u; const float pe = __builtin_amdgcn_exp2f(st[i] + bias[i]); st[i] = valid ? pe : 0.f; }
    u32x4 onesw; onesw.x = 0x3f803f80u; onesw.y = 0x3f803f80u; onesw.z = 0x3f803f80u; onesw.w = 0x3f803f80u;
    const bf16x8 ones = __builtin_bit_cast(bf16x8, onesw);
#pragma unroll
    for (int t = 0; t < 2; ++t) {
        u32x4 pw; pw.x = pk2(st[8 * t + 0], st[8 * t + 1]); pw.y = pk2(st[8 * t + 2], st[8 * t + 3]); pw.z = pk2(st[8 * t + 4], st[8 * t + 5]); pw.w = pk2(st[8 * t + 6], st[8 * t + 7]);
        const bf16x8 pf = __builtin_bit_cast(bf16x8, pw);
        __builtin_amdgcn_s_setprio(1);
        o0 = MFMA32(vf0[t], pf, o0);
        o1 = MFMA32(vf1[t], pf, o1);
        lacc = MFMA32(ones, pf, lacc);
        __builtin_amdgcn_s_setprio(0);
    }
}
__device__ __forceinline__ void attn_phase(LAS unsigned char* lds, const bf16_t* Q, const bf16_t* K, const bf16_t* V, bf16_t* O, const float* rpb, bool ctxq, int bid, int G, int revimg) {
    int tid_ = threadIdx.x; asm volatile("" : "+v"(tid_));
    const int tid = tid_, lane = tid & 63, w = __builtin_amdgcn_readfirstlane(tid >> 6), hi = lane >> 5, l31 = lane & 31;
    LAS float* rp = (LAS float*)(lds + AT_RPB);
    const int srow = tid >> 3, sch = tid & 7;
    const int nlat = NB * NH * 32;
    const int nun = nlat + (ctxq ? NB * NH : 0);
    const bool xmap = (G == 256);
    for (int it = 0; ; ++it) {
        int un = bid + it * G;
        if (un >= nun) break;
        const bool isctx = un >= nlat;
        int b, h, rq = 0, nwin = 0, kr_lo = 0, r_w = 0, rs_w = 0, qc = 0, r0 = 0, rs_lo = 0, rs_hi = 0, kb0 = 0; size_t tq;
        if (!isctx) {
            if (xmap) { int img = (bid & 7) + 8 * it; if (revimg) img = NB * NH - 1 - img; rq = bid >> 3; h = img & 15; b = img >> 4; }
            else { rq = un & 31; h = (un >> 5) & 15; b = un >> 9; }
            kr_lo = rstart(4 * rq); nwin = rstart(4 * rq + 3) + 8 - kr_lo;
            r0 = 4 * rq + 2 * (w >> 2); r_w = r0 + ((l31 >> 4) & 1); rs_w = rstart(r_w); qc = 16 * (w & 3) + (l31 & 15);
            rs_lo = rstart(r0); rs_hi = rstart(r0 + 1) + 8; kb0 = min(max(16 * (w & 3) - 8, 0), 32);
            tq = (size_t)b * SEQ + r_w * GW + qc; }
        else { const int v = un - nlat; h = v & 15; b = v >> 4; tq = (size_t)ML + b * CTX + 32 * w + l31; }
        const int T = nwin + 4;
        const int cs = min(max(qc - 8, 0), GW - 16);
        const int wcs = cs - kb0 - 4 * hi;
        bf16x8 qf[4];
        { const bf16_t* qp = Q + tq * D + 64 * h + 8 * hi;
#pragma unroll
          for (int s = 0; s < 4; ++s) qf[s] = *(const bf16x8*)(qp + 16 * s); }
        if (!isctx) for (int i = tid; i < 465; i += NTHR) rp[i] = rpb[h * 465 + i] * LOG2E;
        f32x16 o0, o1, lacc;
#pragma unroll
        for (int i = 0; i < 16; ++i) { o0[i] = 0.f; o1[i] = 0.f; lacc[i] = 0.f; }
        const size_t ctxbase = (size_t)ML + b * CTX, latbase = (size_t)b * SEQ;
        const size_t coloff = (size_t)srow * D + 64 * h + 8 * sch;
#define AT_TILE_OFF(jj) ((((jj) < nwin) ? latbase + (size_t)(kr_lo + (jj)) * GW : ctxbase + 64 * ((jj) - nwin)) * D + coloff)
#define AT_LOAD(kr_, vr_, jj) do { const size_t off_ = AT_TILE_OFF(jj); kr_ = *(const u32x4*)(K + off_); vr_ = *(const u32x4*)(V + off_); } while (0)
#define AT_WRITE(kr_, vr_, bufi) do { LAS unsigned char* kt_ = lds + AT_KT + (bufi) * KT_SZ; LAS unsigned char* vt_ = lds + AT_VT + (bufi) * VT_SZ; \
            *(LAS u32x4*)(kt_ + srow * 144 + sch * 16) = kr_; *(LAS u32x4*)(vt_ + srow * VT_PITCH + sch * 16) = vr_; } while (0)
#define AT_COMPUTE(jj, bufi) do { const LAS unsigned char* kt_ = lds + AT_KT + (bufi) * KT_SZ; const LAS unsigned char* vt_ = lds + AT_VT + (bufi) * VT_SZ; const int kr_ = kr_lo + (jj); \
            if ((jj) >= nwin) attn_tile<0>(kt_, vt_, rp, 0, qf, l31, hi, o0, o1, lacc); \
            else if (kr_ >= rs_lo && kr_ < rs_hi) { const LAS float* rpl_ = rp + ((kr_ - r_w + 7) * 31 + 15 - qc + kb0 + 4 * hi); \
                const int wcsr_ = ((unsigned)(kr_ - rs_w) < 8u) ? wcs : 4096;     \
                attn_wtile(kt_, vt_, rpl_, wcsr_, kb0, qf, l31, hi, o0, o1, lacc); } } while (0)
        u32x4 k0r, v0r, k1r, v1r;
        AT_LOAD(k0r, v0r, 0); AT_LOAD(k1r, v1r, 1);
        AT_WRITE(k0r, v0r, 0);
        __syncthreads();
        int j = 0;
        for (; j + 1 < T; j += 2) {
            { const int jl = min(j + 2, T - 1); AT_LOAD(k0r, v0r, jl); }
            AT_COMPUTE(j, 0);
            AT_WRITE(k1r, v1r, 1);
            __syncthreads();
            { const int jl = min(j + 3, T - 1); AT_LOAD(k1r, v1r, jl); }
            AT_COMPUTE(j + 1, 1);
            AT_WRITE(k0r, v0r, 0);
            __syncthreads();
        }
        if (j < T) { AT_COMPUTE(j, 0); __syncthreads(); }
#undef AT_TILE_OFF
#undef AT_LOAD
#undef AT_WRITE
#undef AT_COMPUTE
        const float inv = 1.0f / lacc[0];
        bf16_t* op = O + tq * D + 64 * h + 4 * hi;
#pragma unroll
        for (int g = 0; g < 4; ++g) { u32x2 wv; wv.x = pk2(o0[4 * g] * inv, o0[4 * g + 1] * inv); wv.y = pk2(o0[4 * g + 2] * inv, o0[4 * g + 3] * inv); *(u32x2*)(op + 8 * g) = wv;
            u32x2 wv1; wv1.x = pk2(o1[4 * g] * inv, o1[4 * g + 1] * inv); wv1.y = pk2(o1[4 * g + 2] * inv, o1[4 * g + 3] * inv); *(u32x2*)(op + 32 + 8 * g) = wv1; }
    }
}

#define XB_TMO      128
#define XB_XCNT(j)  (256  + 64 * (j))
#define XB_XSUB(j)  (1280 + 64 * (j))
#define XB_XGEN(j)  (2304 + 64 * (j))
#define XB_TOP      3328
#define XB_TOPGEN   3392
#define XCD_BAR_WORDS 3456
#define XB_SPIN_CAP (1u << 18)

__device__ __forceinline__ unsigned xb_ld(unsigned* p)              { return __hip_atomic_load(p, __ATOMIC_RELAXED, __HIP_MEMORY_SCOPE_AGENT); }
__device__ __forceinline__ unsigned xb_add(unsigned* p, unsigned v) { return __hip_atomic_fetch_add(p, v, __ATOMIC_RELAXED, __HIP_MEMORY_SCOPE_AGENT); }
__device__ __forceinline__ unsigned xb_xcc_id() { return (unsigned)__builtin_amdgcn_s_getreg((3 << 11) | 20) & 0xFu; }
#define XB_SPIN(cond, bar) do { unsigned _sp = 0; while (cond) { __builtin_amdgcn_s_sleep(1); \
    if ((++_sp & 255u) == 0u) { if (xb_ld(&(bar)[XB_TMO])) break; if (_sp > XB_SPIN_CAP) { atomicAdd(&(bar)[XB_TMO], 1u); break; } } } } while (0)

struct XcdBarrier {
    unsigned* bar; unsigned x;
    volatile LAS unsigned* st;
};

__device__ __forceinline__ XcdBarrier xcd_barrier_post(unsigned* bar, volatile LAS unsigned* st) {
    XcdBarrier b; b.bar = bar; b.x = xb_xcc_id(); b.st = st;
    if (threadIdx.x == 0) (void)xb_add(&bar[XB_XCNT(b.x)], 1u);
    return b;
}
__device__ __forceinline__ void xcd_barrier_complete(unsigned* bar, unsigned x, unsigned& nloc, unsigned& nx) {
    const unsigned G = gridDim.x * gridDim.y * gridDim.z;
    unsigned sum, cnt, mine, sp = 0u;
    for (;;) {
        sum = 0u; cnt = 0u; mine = 0u;
#pragma unroll
        for (unsigned j = 0; j < 16; ++j) { const unsigned c = xb_ld(&bar[XB_XCNT(j)]); sum += c; cnt += (c > 0u) ? 1u : 0u; mine = (j == x) ? c : mine; }
        if (sum == G) break;
        __builtin_amdgcn_s_sleep(1);
        if ((++sp & 255u) == 0u) { if (xb_ld(&bar[XB_TMO])) break; if (sp > XB_SPIN_CAP) { atomicAdd(&bar[XB_TMO], 1u); break; } }
    }
    nloc = mine > 0u ? mine : 1u; nx = cnt > 0u ? cnt : 1u;
}

__device__ __forceinline__ void xcd_barrier(const XcdBarrier& b) {
    asm volatile("s_waitcnt vmcnt(0)" ::: "memory");
    __syncthreads();
    if (threadIdx.x == 0) {
        unsigned* bar = b.bar;
        __builtin_amdgcn_s_waitcnt(0);
        unsigned nloc = b.st[0], nx = b.st[1];
        if (nloc == 0u) { xcd_barrier_complete(bar, b.x, nloc, nx); b.st[0] = nloc; b.st[1] = nx; }
        const unsigned old = xb_add(&bar[XB_XSUB(b.x)], 1u);
        const unsigned gen = old / nloc;
        if (old + 1u == (gen + 1u) * nloc) {
            __builtin_amdgcn_fence(__ATOMIC_RELEASE, "agent");
            asm volatile("s_waitcnt vmcnt(0)" ::: "memory");
            const unsigned og = xb_add(&bar[XB_TOP], 1u);
            const unsigned tg = og / nx;
            if (og + 1u == (tg + 1u) * nx) xb_add(&bar[XB_TOPGEN], 1u);
            else XB_SPIN(xb_ld(&bar[XB_TOPGEN]) == tg, bar);
            __builtin_amdgcn_fence(__ATOMIC_ACQUIRE, "agent");
            xb_add(&bar[XB_XGEN(b.x)], 1u);
            asm volatile("s_waitcnt vmcnt(0)" ::: "memory");
        } else {
            XB_SPIN(xb_ld(&bar[XB_XGEN(b.x)]) == gen, bar);
            __builtin_amdgcn_fence(__ATOMIC_ACQUIRE, "agent");
            asm volatile("s_waitcnt vmcnt(0)" ::: "memory");
        }
    }
    __syncthreads();
}

#ifndef REV_G1
#define REV_G1 1
#define REV_G2 0
#define REV_F1 1
#define REV_F2 0
#endif
#ifdef PROBE_SYNC2
#define GSYNC() do { xcd_barrier(xbar); xcd_barrier(xbar); } while (0)
#else
#define GSYNC() xcd_barrier(xbar)
#endif
__global__ void __launch_bounds__(NTHR, 2) mega_fwd(Params P) {
    extern __shared__ __attribute__((aligned(16))) unsigned char lds_raw[];
    LAS unsigned char* lds = (LAS unsigned char*)lds_raw;
    cg::grid_group grid = cg::this_grid();
    const int tid = threadIdx.x, lane = tid & 63, wave = __builtin_amdgcn_readfirstlane(tid >> 6);
    const int G = gridDim.x, bid = blockIdx.x;
    const int gw = bid * NWAVE + wave, ngw = G * NWAVE;
    unsigned char* ws = P.ws;
    volatile LAS unsigned* xst = (volatile LAS unsigned*)(lds + 131072);
    if (tid < 2) xst[tid] = 0u;
    __syncthreads();
    const XcdBarrier xbar = xcd_barrier_post((unsigned*)(ws + WS_BAR), xst);
    float* MOD = (float*)(ws + WS_MOD); float* SWM = (float*)(ws + WS_SWM); float* SWF = (float*)(ws + WS_SWF); float* RSS = (float*)(ws + WS_RSS); float* XC = (float*)(ws + WS_XC);
    bf16_t* XS = (bf16_t*)(ws + WS_XS); bf16_t* A0 = (bf16_t*)(ws + WS_A0); bf16_t* A1 = (bf16_t*)(ws + WS_A1); bf16_t* A2 = (bf16_t*)(ws + WS_A2); bf16_t* A3 = (bf16_t*)(ws + WS_A3); bf16_t* GG = (bf16_t*)(ws + WS_G);

#ifdef PROBE_PRO2
    for (int rep_ = 0; rep_ < 2; ++rep_) { if (rep_) GSYNC();
#endif
    {
        LAS float* vl = (LAS float*)lds; LAS float* red = (LAS float*)(lds + 49152);
        for (int idx = tid; idx < NS * D; idx += NTHR) { const int s = idx >> 10, k = idx & 1023; const float c = s < 8 ? P.in[I_C][s * D + k] : P.in[I_CCTX][k]; vl[k * 12 + s] = c / (1.0f + __expf(-c)); }
        __syncthreads();
        for (int task = bid; task < DEPTH * 48; task += G) { const int i = task / 48, cc = task % 48;
            gemv9_task(vl, red, P.in[I_WADA] + (size_t)i * D * 6144, 6144, cc * 128, MOD + (size_t)i * NS * 6144, 6144, P.in[I_BADA] + i * 6144); }
        for (int idx = bid * NTHR + tid; idx < 8 * MA; idx += G * NTHR) RSS[idx] = 0.f;
        __syncthreads();
        LAS float* scr = (LAS float*)(lds + wave * 16384);
        constexpr int IT_MIXIN = 16 * 96, IT_MIXOUT = 16 * 32, IT_FFNIN = 16 * 176, IT_FFNOUT = 44 * 32, IT_LAYER = IT_MIXIN + IT_MIXOUT + IT_FFNIN + IT_FFNOUT;
        for (int it = gw; it < DEPTH * IT_LAYER; it += ngw) {
            const int i = it / IT_LAYER; int r = it % IT_LAYER; const int j = i >> 1; const bool conv = (i & 1) == 0;
            unsigned char* wt = ws + WS_WT + (size_t)i * WT_LAYER;
            if (r < IT_MIXIN) { const int kb = r / 96, g = r % 96, pn = g >> 3, bj = (g >> 2) & 1, wc = g & 3;
                const int src0 = conv ? (pn < 4 ? 256 * pn + 128 * bj + 32 * wc : 1024 * (1 + bj) + 128 * (pn - 4) + 32 * wc) : (1024 * (pn >> 2) + 64 * (4 * (pn & 3) + wc) + 32 * bj);
                const float* W = conv ? P.in[I_CWIN] + (size_t)j * D * 3072 : P.in[I_AQKV] + (size_t)j * D * 3072;
                transpose_item(W, D, 3072, (bf16_t*)(wt + WT_MIXIN), src0, 32 * g, true, 64 * kb, scr, lane); continue; }
            r -= IT_MIXIN;
            if (r < IT_MIXOUT) { const int kb = r / 32, g = r % 32; const float* W = conv ? P.in[I_CWOUT] + (size_t)j * D * D : P.in[I_AWOUT] + (size_t)j * D * D;
                transpose_item(W, D, D, (bf16_t*)(wt + WT_MIXOUT), 32 * g, 32 * g, false, 64 * kb, scr, lane); continue; }
            r -= IT_MIXOUT;
            if (r < IT_FFNIN) { const int kb = r / 176, g = r % 176, pn = g >> 3, bj = (g >> 2) & 1, wc = g & 3; const int src0 = FF * bj + 128 * pn + 32 * wc;
                transpose_item(P.in[I_FWIN] + (size_t)i * D * 2 * FF, D, 2 * FF, (bf16_t*)(wt + WT_FFNIN), src0, 32 * g, true, 64 * kb, scr, lane); continue; }
            r -= IT_FFNIN;
            { const int kb = r / 32, g = r % 32; transpose_item(P.in[I_FWOUT] + (size_t)i * FF * D, FF, D, (bf16_t*)(wt + WT_FFNOUT), 32 * g, 32 * g, false, 64 * kb, scr, lane); }
        }
    }
#ifdef PROBE_PRO2
    }
#endif
    if (P.ws == nullptr) grid.sync();
    GSYNC();
#ifdef PROBE_PRO2
    for (int rep_ = 0; rep_ < 2; ++rep_) { if (rep_) GSYNC();
#endif
    {
        LAS float* vl = (LAS float*)lds; LAS float* red = (LAS float*)(lds + 49152);
        for (int task = bid; task < DEPTH * 68; task += G) { const int i = task / 68; int r = task % 68; const int j = i >> 1;
            const bool mix = r < 24; const int voff = mix ? 0 : 3 * D;
            for (int idx = tid; idx < NS * D; idx += NTHR) { const int s = idx >> 10, k = idx & 1023; vl[k * 12 + s] = MOD[(size_t)(i * NS + s) * 6144 + voff + k]; }
            __syncthreads();
            if (mix) { const float* W = (i & 1) == 0 ? P.in[I_CWIN] + (size_t)j * D * 3072 : P.in[I_AQKV] + (size_t)j * D * 3072;
                gemv9_task(vl, red, W, 3072, r * 128, SWM + (size_t)i * NS * 3072, 3072, nullptr); }
            else { r -= 24; gemv9_task(vl, red, P.in[I_FWIN] + (size_t)i * D * 2 * FF, 2 * FF, r * 128, SWF + (size_t)i * NS * 2 * FF, 2 * FF, nullptr); }
        }
        for (int row0 = gw; row0 < MA; row0 += 4 * ngw) {
            f32x4 v[4][4];
#pragma unroll
            for (int r = 0; r < 4; ++r) { const int row = min(row0 + r * ngw, MA - 1); const bool lat = row < ML;
                const float* src = lat ? P.in[I_X] + (size_t)row * D : P.in[I_CTX] + (size_t)(row - ML) * D;
#pragma unroll
                for (int q = 0; q < 4; ++q) v[r][q] = ((const f32x4*)src)[lane + 64 * q]; }
            asm volatile("" ::: "memory");
#pragma unroll
            for (int r = 0; r < 4; ++r) { const int row = row0 + r * ngw; if (row < MA) { const bool lat = row < ML; const int s = lat ? (row >> 13) : 8;
                float ss = 0.f;
#pragma unroll
                for (int q = 0; q < 4; ++q) ss += (v[r][q][0] * v[r][q][0] + v[r][q][1] * v[r][q][1]) + (v[r][q][2] * v[r][q][2] + v[r][q][3] * v[r][q][3]);
                ss = wave_sum(ss);
                if (lane == 0) RSS[row] = ss;
#pragma unroll
                for (int q = 0; q < 4; ++q) { const int c = 4 * (lane + 64 * q); const f32x4 nv = *(const f32x4*)(P.in[I_NMIX] + c) * (*(const f32x4*)(MOD + (size_t)s * 6144 + D + c) + 1.0f); const f32x4 y = v[r][q] * nv;
                    u32x2 wv; wv.x = pk2(y[0], y[1]); wv.y = pk2(y[2], y[3]); *(u32x2*)(XS + (size_t)row * D + c) = wv; } } }
        }
    }
#ifdef PROBE_PRO2
    }
#endif
    GSYNC();
    int dirw = 0;
    for (int i = 0; i < DEPTH; ++i) {
        const int j = i >> 1; const bool conv = (i & 1) == 0; const bool last = i == DEPTH - 1;
        unsigned char* wt = ws + WS_WT + (size_t)i * WT_LAYER;
        const float* modi = MOD + (size_t)i * NS * 6144;
        float* rssA = RSS + (size_t)(2 * i) * MA; float* rssB = RSS + (size_t)(2 * i + 1) * MA;
        const int Mr = last ? ML : MA;
        const float* xin_l = i == 0 ? P.in[I_X] : P.out; const float* xin_c = i == 0 ? P.in[I_CTX] : XC;
        if (conv) {
            { pg8::Gemm g{XS, (const bf16_t*)(wt + WT_MIXIN), MA, 3072, D}; pg8::StaticOrder S; S.init(MA, 3072, G, bid); S.rev = !dirw; dirw = S.rev;
              EpiConvIn E{rssA, SWM + (size_t)i * NS * 3072, A0, A1};
#ifndef SKIP_G1C
              pg8::gemm_phase<EpiConvIn, pg8::StaticOrder, false, true>(lds, g, S, E);
#ifdef PROBE_GEMM2
              pg8::gemm_phase<EpiConvIn, pg8::StaticOrder, false, true>(lds, g, S, E);
#endif
#endif
 }
            GSYNC();
#ifndef SKIP_CONV
            conv_phase(A0, A1, A3, P.in[I_CW] + (size_t)j * 3 * D, gw, ngw, lane);
#ifdef PROBE_CONV2
            GSYNC();
            conv_phase(A0, A1, A3, P.in[I_CW] + (size_t)j * 3 * D, gw, ngw, lane);
#endif
#endif
            GSYNC();
        } else {
            { pg8::Gemm g{XS, (const bf16_t*)(wt + WT_MIXIN), MA, 3072, D}; pg8::StaticOrder S; S.init(MA, 3072, G, bid); S.rev = !dirw; dirw = S.rev;
              EpiQKV E{rssA, SWM + (size_t)i * NS * 3072, P.in[I_AQN] + j * HD, P.in[I_AKN] + j * HD, A0};
#ifndef SKIP_G1Q
              pg8::gemm_phase<EpiQKV, pg8::StaticOrder, true, true>(lds, g, S, E);
#ifdef PROBE_GEMM2
              pg8::gemm_phase<EpiQKV, pg8::StaticOrder, true, true>(lds, g, S, E);
#endif
#endif
 }
            GSYNC();
#ifndef SKIP_ATTN
            dirw = !dirw;
            attn_phase(lds, A0, A1, A2, A3, P.in[I_ARPB] + (size_t)j * NH * 465, !last, bid, G, dirw);
#ifdef PROBE_ATTN2
            GSYNC();
            attn_phase(lds, A0, A1, A2, A3, P.in[I_ARPB] + (size_t)j * NH * 465, !last, bid, G, dirw);
#endif
#endif
            GSYNC();
        }
        { pg8::Gemm g{A3, (const bf16_t*)(wt + WT_MIXOUT), Mr, D, D}; pg8::StaticOrder S; S.init(Mr, D, G, bid); S.rev = !dirw; dirw = S.rev;
          EpiRes E{xin_l, xin_c, P.out, XC, modi + 2 * D, P.in[I_NFFN] + i * D, modi + 4 * D, XS, rssB};
#ifndef SKIP_G2
#ifdef PROBE_RES2
          { EpiRes E2{xin_l, xin_c, (float*)A0, (float*)A0 + (size_t)ML * D, modi + 2 * D, nullptr, modi + 4 * D, XS, rssB};
            pg8::gemm_phase<EpiRes, pg8::StaticOrder, true, true>(lds, g, S, E2); GSYNC(); }
#endif
          pg8::gemm_phase<EpiRes, pg8::StaticOrder, false, true>(lds, g, S, E);
#endif
 }
        GSYNC();
        { pg8::Gemm g{XS, (const bf16_t*)(wt + WT_FFNIN), Mr, 2 * FF, D}; pg8::StaticOrder S; S.init(Mr, 2 * FF, G, bid); S.rev = !dirw; dirw = S.rev;
          EpiSwi E{rssB, SWF + (size_t)i * NS * 2 * FF, GG};
#ifndef SKIP_F1
          pg8::gemm_phase<EpiSwi, pg8::StaticOrder, true, true>(lds, g, S, E);
#ifdef PROBE_GEMM2
          pg8::gemm_phase<EpiSwi, pg8::StaticOrder, true, true>(lds, g, S, E);
#endif
#endif
 }
        GSYNC();
        { pg8::Gemm g{GG, (const bf16_t*)(wt + WT_FFNOUT), Mr, D, FF}; pg8::StaticOrder S; S.init(Mr, D, G, bid); S.rev = !dirw; dirw = S.rev;
          EpiRes E{P.out, XC, P.out, XC, modi + 5 * D, last ? nullptr : P.in[I_NMIX] + (i + 1) * D, modi + NS * 6144 + D, XS, rssA + 2 * MA};
#ifndef SKIP_F2
#ifdef PROBE_RES2
          { EpiRes E2{P.out, XC, P.out, XC, (const float*)(ws + WS_ZERO), nullptr, modi + 4 * D, XS, rssB};
            pg8::gemm_phase<EpiRes, pg8::StaticOrder, true, true>(lds, g, S, E2); GSYNC(); }
#endif
          pg8::gemm_phase<EpiRes, pg8::StaticOrder, false, true>(lds, g, S, E);
#endif
 }
        if (!last) GSYNC();
    }
}

extern "C" void kernel_launch(void* const* d_in, const int* in_sizes, int n_in, void* d_out, int out_size, void* d_ws, size_t ws_size, hipStream_t stream) {
    static int grid = 0;
    if (grid == 0) {
        if (n_in != 18 || out_size != ML * D || ws_size < WS_END) { fprintf(stderr, "kernel_launch: unexpected shapes (n_in %d, out %d, ws %zu, need %zu)\n", n_in, out_size, ws_size, (size_t)WS_END); grid = -1; return; }
        int dev = 0, cus = 0, per_cu = 0;
        if (hipGetDevice(&dev) != hipSuccess || hipDeviceGetAttribute(&cus, hipDeviceAttributeMultiprocessorCount, dev) != hipSuccess) { grid = -1; return; }
        if (hipFuncSetAttribute((const void*)mega_fwd, hipFuncAttributeMaxDynamicSharedMemorySize, LDS_BYTES) != hipSuccess) { fprintf(stderr, "kernel_launch: hipFuncSetAttribute failed\n"); grid = -1; return; }
        if (hipOccupancyMaxActiveBlocksPerMultiprocessor(&per_cu, (const void*)mega_fwd, NTHR, LDS_BYTES) != hipSuccess || per_cu < 1) { fprintf(stderr, "kernel_launch: occupancy query says %d\n", per_cu); per_cu = 1; }
        (void)hipGetLastError();
        grid = cus;
    }
    if (grid < 0) return;
    if (hipMemsetAsync((char*)d_ws + WS_BAR, 0, BAR_BYTES, stream) != hipSuccess) { fprintf(stderr, "kernel_launch: memset failed\n"); return; }
#ifdef PROBE_RES2
    (void)hipMemsetAsync((char*)d_ws + WS_ZERO, 0, ZERO_BYTES, stream);
#endif
    Params p{};
    for (int i = 0; i < 18; ++i) p.in[i] = (const float*)d_in[i];
    p.out = (float*)d_out; p.ws = (unsigned char*)d_ws;
    void* args[] = {&p};
    hipError_t e = hipLaunchCooperativeKernel((const void*)mega_fwd, dim3(grid), dim3(NTHR), args, LDS_BYTES, stream);
    if (e != hipSuccess) fprintf(stderr, "kernel_launch: cooperative launch failed: %s (grid %d)\n", hipGetErrorString(e), grid);
}
```

```cpp
#include <hip/hip_runtime.h>
#include <hip/hip_cooperative_groups.h>
#include <cstdio>
#include <cstdint>
namespace cg = cooperative_groups;
namespace pg8 {
#define PG8_LAS __attribute__((address_space(3)))
typedef unsigned short bf16_t;
typedef short bf16x8 __attribute__((ext_vector_type(8)));
typedef float f32x4 __attribute__((ext_vector_type(4)));
typedef unsigned u32x4 __attribute__((ext_vector_type(4)));
constexpr int BM = 256, BK = 64, HALF = 128, HTB = HALF * BK * 2  , STAGE_BYTES = 8 * HTB, NXCD = 8, WGM = 4;

__host__ __device__ __forceinline__ int lds_byte(int r, int c) { const int st = (r >> 4) * 2 + (c >> 5), rr = r & 15, cc = c & 31, ob = rr * 64 + cc * 2; return st * 1024 + (ob ^ (((ob >> 9) & 1) << 5)); }
__host__ __device__ __forceinline__ void stage_rc(int b, int& R, int& C) { const int st = b / 1024, sb = b % 1024, swz = sb ^ (((sb >> 9) & 1) << 5); R = (st >> 1) * 16 + swz / 64; C = (st & 1) * 32 + (swz % 64) / 2; }
__host__ __device__ __forceinline__ int perm32(int rho) { const int n = rho >> 4, i = rho & 15; return 8 * (i >> 2) + 4 * n + (i & 3); }

struct Unit { int pm, pn; };
struct Gemm { const bf16_t* A; const bf16_t* Bt; int M, N, K; };

struct StaticOrder {
    int nM, nN, nwg, G, c, rev;
    __host__ __device__ void init(int M, int N, int G_, int c_) { nM = M / BM; nN = N / BM; nwg = nM * nN; G = G_; c = c_; rev = 0; }
    __host__ __device__ bool next(int i, Unit& u) const {
        const long L = (long)i * G + c; if (L >= nwg) return false;
        int wgid = rev ? (int)(nwg - 1 - L) : (int)L; { const int q = nwg / NXCD, r = nwg % NXCD, xcd = wgid % NXCD, off = wgid / NXCD; wgid = (xcd < r ? xcd * (q + 1) : r * (q + 1) + (xcd - r) * q) + off; }
        const int nig = WGM * nN, gid = wgid / nig, fm = gid * WGM, gsz = (nM - fm) < WGM ? (nM - fm) : WGM;
        u.pm = fm + ((wgid % nig) % gsz); u.pn = (wgid % nig) / gsz; return true;
    }
    __device__ __forceinline__ void a_ready(const Unit&) const {}
    __device__ __forceinline__ void done(const Unit&) const {}
};

template <class Epi, class Sched, bool ALIGN_EPI = false, bool SP2 = false>
__device__ __forceinline__ void gemm_phase(PG8_LAS unsigned char* lds, const Gemm g, const Sched& S, const Epi& E) {
    int tid_ = threadIdx.x; asm volatile("" : "+v"(tid_));
    const int tid = tid_, wid = __builtin_amdgcn_readfirstlane(tid >> 6), lane = tid & 63, wr = wid >> 2, wc = wid & 3, fr = lane & 15, fq = lane >> 4;
    const int K = g.K, nt = K / BK;
    unsigned voffA[2], voffB[2];
#pragma unroll
    for (int i = 0; i < 2; ++i) { int R, C; stage_rc(tid * 16 + i * 8192, R, C); const int Rb = Epi::PERM ? ((R & ~31) + perm32(R & 31)) : R;
        voffA[i] = (unsigned)(R * K + C) * 2u; voffB[i] = (unsigned)(Rb * K + C) * 2u; }
    const size_t kstep = (size_t)(BK * 2);
    const size_t hstep = (size_t)HALF * K * 2;
    const size_t tstep = 2 * hstep;
    const unsigned ldsw = (unsigned)wid * 1024u;
    const int aoff = lds_byte(wr * 64 + fr, fq * 8), boff = lds_byte(wc * 32 + fr, fq * 8);
#define PG8_SA(b, h) (((b) * 2 + (h)) * HTB)
#define PG8_SB(b, h) ((4 + (b) * 2 + (h)) * HTB)
#define PG8_STAGE(bufoff, gbase, voff) do { _Pragma("unroll") for (int _i = 0; _i < 2; ++_i) \
        __builtin_amdgcn_global_load_lds((const unsigned*)((const char*)(gbase) + (voff)[_i]), (PG8_LAS unsigned*)(lds + (bufoff) + ldsw + _i * 8192), 16, 0, 0); } while (0)
#define PG8_LDA(dst, b, h) do { _Pragma("unroll") for (int m = 0; m < 4; ++m) _Pragma("unroll") for (int k = 0; k < 2; ++k) dst[m][k] = *(const PG8_LAS bf16x8*)(lds + PG8_SA(b, h) + aoff + m * 2048 + k * 1024); } while (0)
#define PG8_LDB(dst, b, h) do { _Pragma("unroll") for (int n = 0; n < 2; ++n) _Pragma("unroll") for (int k = 0; k < 2; ++k) dst[n][k] = *(const PG8_LAS bf16x8*)(lds + PG8_SB(b, h) + boff + n * 2048 + k * 1024); } while (0)
#define PG8_MMA(ai, bj, At, Bt) do { __builtin_amdgcn_s_setprio(1); _Pragma("unroll") for (int m = 0; m < 4; ++m) _Pragma("unroll") for (int n = 0; n < 2; ++n) _Pragma("unroll") for (int k = 0; k < 2; ++k) \
        acc[ai][bj][m][n] = __builtin_amdgcn_mfma_f32_16x16x32_bf16(Bt[n][k], At[m][k], acc[ai][bj][m][n], 0, 0, 0); __builtin_amdgcn_s_setprio(0); } while (0)
#define PG8_WAIT_V(n) asm volatile("s_waitcnt vmcnt(" #n ")" ::: "memory")
#define PG8_WAIT_L(n) asm volatile("s_waitcnt lgkmcnt(" #n ")" ::: "memory")
#define PG8_BAR __builtin_amdgcn_s_barrier()
#define PG8_SCHED __builtin_amdgcn_sched_barrier(0)
    Unit cur, nxt; int ui = 0;
    if (!S.next(0, cur)) return;
    f32x4 acc[2][2][4][2];
#pragma unroll
    for (int a = 0; a < 2; ++a)
#pragma unroll
        for (int b = 0; b < 2; ++b)
#pragma unroll
            for (int m = 0; m < 4; ++m)
#pragma unroll
                for (int n = 0; n < 2; ++n) acc[a][b][m][n] = (f32x4){0.f, 0.f, 0.f, 0.f};
    bf16x8 At[4][2], B0[2][2], B1[2][2];
    const char* cA = (const char*)g.A + (size_t)cur.pm * tstep; const char* cB = (const char*)g.Bt + (size_t)cur.pn * tstep;
    S.a_ready(cur);
    if constexpr (SP2) {
        PG8_STAGE(PG8_SB(0, 0), cB, voffB); PG8_STAGE(PG8_SB(0, 1), cB + hstep, voffB); PG8_STAGE(PG8_SA(0, 0), cA, voffA); PG8_STAGE(PG8_SA(0, 1), cA + hstep, voffA);
        if (wr == 1) PG8_BAR;
        PG8_WAIT_V(2); PG8_BAR;
        PG8_STAGE(PG8_SB(1, 0), cB + kstep, voffB); PG8_STAGE(PG8_SA(1, 0), cA + kstep, voffA); PG8_STAGE(PG8_SB(1, 1), cB + hstep + kstep, voffB);
        PG8_WAIT_V(6); PG8_BAR;
    } else {
        PG8_STAGE(PG8_SB(0, 0), cB, voffB); PG8_STAGE(PG8_SA(0, 0), cA, voffA); PG8_STAGE(PG8_SB(0, 1), cB + hstep, voffB); PG8_STAGE(PG8_SA(0, 1), cA + hstep, voffA);
        if (wr == 1) PG8_BAR;
        PG8_WAIT_V(4); PG8_BAR;
        PG8_STAGE(PG8_SB(1, 0), cB + kstep, voffB); PG8_STAGE(PG8_SA(1, 0), cA + kstep, voffA); PG8_STAGE(PG8_SB(1, 1), cB + hstep + kstep, voffB);
        PG8_WAIT_V(6); PG8_BAR;
    }
    for (;;) {
        const bool has_next = S.next(ui + 1, nxt);
        const char* nA = has_next ? (const char*)g.A + (size_t)nxt.pm * tstep : cA; const char* nB = has_next ? (const char*)g.Bt + (size_t)nxt.pn * tstep : cB;
        for (int t = 0; t < nt; t += 2) {
            const bool last = (t == nt - 2);
            const char* a1 = cA + (size_t)(t + 1) * kstep;
            const char* a2 = last ? nA : cA + (size_t)(t + 2) * kstep; const char* b2 = last ? nB : cB + (size_t)(t + 2) * kstep;
            const char* a3 = a2 + kstep; const char* b3 = b2 + kstep;
            if (last && has_next) S.a_ready(nxt);
            if constexpr (SP2) {
            PG8_LDB(B0, 0, 0); PG8_LDB(B1, 0, 1); PG8_SCHED; PG8_LDA(At, 0, 0); PG8_STAGE(PG8_SA(1, 1), a1 + hstep, voffA);
            PG8_WAIT_V(8); PG8_WAIT_L(0); PG8_BAR; PG8_MMA(0, 0, At, B0); PG8_MMA(0, 1, At, B1); PG8_BAR; PG8_SCHED;
            PG8_LDA(At, 0, 1); PG8_STAGE(PG8_SB(0, 0), b2, voffB); PG8_STAGE(PG8_SB(0, 1), b2 + hstep, voffB); PG8_STAGE(PG8_SA(0, 0), a2, voffA);
            PG8_WAIT_V(8); PG8_WAIT_L(0); PG8_BAR; PG8_MMA(1, 0, At, B0); PG8_MMA(1, 1, At, B1); PG8_BAR; PG8_SCHED;
            PG8_LDB(B0, 1, 0); PG8_LDB(B1, 1, 1); PG8_SCHED; PG8_LDA(At, 1, 0); PG8_STAGE(PG8_SA(0, 1), a2 + hstep, voffA);
            PG8_WAIT_V(8); PG8_WAIT_L(0); PG8_BAR; PG8_MMA(0, 0, At, B0); PG8_MMA(0, 1, At, B1); PG8_BAR; PG8_SCHED;
            PG8_LDA(At, 1, 1); PG8_STAGE(PG8_SB(1, 0), b3, voffB); PG8_STAGE(PG8_SB(1, 1), b3 + hstep, voffB); PG8_STAGE(PG8_SA(1, 0), a3, voffA);
            PG8_WAIT_V(8); PG8_WAIT_L(0); PG8_BAR; PG8_MMA(1, 0, At, B0); PG8_MMA(1, 1, At, B1); PG8_BAR; PG8_SCHED;
            } else {
            PG8_LDB(B0, 0, 0); PG8_SCHED; PG8_LDA(At, 0, 0); PG8_STAGE(PG8_SA(1, 1), a1 + hstep, voffA);
            PG8_WAIT_L(8); PG8_BAR; PG8_WAIT_L(0); PG8_MMA(0, 0, At, B0); PG8_BAR; PG8_SCHED;
            PG8_LDB(B1, 0, 1); PG8_STAGE(PG8_SB(0, 0), b2, voffB);
            PG8_BAR; PG8_WAIT_L(0); PG8_MMA(0, 1, At, B1); PG8_BAR;
            PG8_LDA(At, 0, 1); PG8_STAGE(PG8_SA(0, 0), a2, voffA);
            PG8_BAR; PG8_WAIT_L(0); PG8_MMA(1, 0, At, B0); PG8_BAR; PG8_SCHED;
            PG8_STAGE(PG8_SB(0, 1), b2 + hstep, voffB);
            PG8_WAIT_V(6); PG8_BAR; PG8_MMA(1, 1, At, B1); PG8_BAR;
            PG8_LDB(B0, 1, 0); PG8_SCHED; PG8_LDA(At, 1, 0); PG8_STAGE(PG8_SA(0, 1), a2 + hstep, voffA);
            PG8_WAIT_L(8); PG8_BAR; PG8_WAIT_L(0); PG8_MMA(0, 0, At, B0); PG8_BAR; PG8_SCHED;
            PG8_LDB(B1, 1, 1); PG8_STAGE(PG8_SB(1, 0), b3, voffB);
            PG8_BAR; PG8_WAIT_L(0); PG8_MMA(0, 1, At, B1); PG8_BAR;
            PG8_LDA(At, 1, 1); PG8_STAGE(PG8_SA(1, 0), a3, voffA);
            PG8_BAR; PG8_WAIT_L(0); PG8_MMA(1, 0, At, B0); PG8_BAR; PG8_SCHED;
            PG8_STAGE(PG8_SB(1, 1), b3 + hstep, voffB);
            PG8_WAIT_V(6); PG8_BAR; PG8_MMA(1, 1, At, B1); PG8_BAR;
            }
        }
        if constexpr (ALIGN_EPI) { if (wr == 0) PG8_BAR; }
        if constexpr (!Epi::AFTER_DRAIN) { E(acc, cur, wr, wc, fr, fq); S.done(cur); }
        if (!has_next) break;
#pragma unroll
        for (int a = 0; a < 2; ++a)
#pragma unroll
            for (int b = 0; b < 2; ++b)
#pragma unroll
                for (int m = 0; m < 4; ++m)
#pragma unroll
                    for (int n = 0; n < 2; ++n) acc[a][b][m][n] = (f32x4){0.f, 0.f, 0.f, 0.f};
        cur = nxt; cA = nA; cB = nB; ++ui;
        if constexpr (ALIGN_EPI) { if (wr == 1) PG8_BAR; }
    }
    PG8_WAIT_V(0);
    if constexpr (!ALIGN_EPI) { if (wr == 0) PG8_BAR; }
    PG8_BAR;
    if constexpr (Epi::AFTER_DRAIN) { E.fused(acc, cur, wr, wc, fr, fq, lds, wid, lane); S.done(cur); }
#undef PG8_SA
#undef PG8_SB
#undef PG8_STAGE
#undef PG8_LDA
#undef PG8_LDB
#undef PG8_MMA
#undef PG8_WAIT_V
#undef PG8_WAIT_L
#undef PG8_BAR
#undef PG8_SCHED
}
}

#define LAS __attribute__((address_space(3)))
using pg8::bf16_t; using pg8::bf16x8; using pg8::f32x4; using pg8::u32x4; using pg8::Unit;
typedef unsigned u32x2 __attribute__((ext_vector_type(2)));
typedef float f32x2 __attribute__((ext_vector_type(2)));
typedef float f32x16 __attribute__((ext_vector_type(16)));
typedef __bf16 bf16v2 __attribute__((ext_vector_type(2)));

constexpr int D = 1024, NB = 8, SEQ = 8192, DEPTH = 4, CTX = 256, NH = 16, HD = 64, FF = 2816, GW = 64;
constexpr int ML = NB * SEQ, MC = NB * CTX, MA = ML + MC;
constexpr int NS = 9;
constexpr float EPS = 1e-6f;
constexpr int NTHR = 512, NWAVE = 8;
constexpr int LDS_BYTES = 147456;

constexpr size_t MiB = 1u << 20;
constexpr size_t WS_MOD = 0;
constexpr size_t WS_SWM = 1 * MiB;
constexpr size_t WS_SWF = 2 * MiB;
constexpr size_t WS_RSS = 3 * MiB;
constexpr size_t WS_XC = 6 * MiB;
constexpr size_t WS_BAR = 15 * MiB, BAR_BYTES = 16384;
#ifdef PROBE_RES2
constexpr size_t WS_ZERO = 15 * MiB + 65536, ZERO_BYTES = 262144;
#endif
constexpr size_t WS_WT = 16 * MiB;
constexpr size_t WT_MIXIN = 0, WT_MIXOUT = (size_t)3072 * 1024 * 2, WT_FFNIN = WT_MIXOUT + (size_t)1024 * 1024 * 2, WT_FFNOUT = WT_FFNIN + (size_t)5632 * 1024 * 2, WT_LAYER = WT_FFNOUT + (size_t)1024 * 2816 * 2;
constexpr size_t WS_XS = 128 * MiB;
constexpr size_t ACT = (size_t)MA * D * 2;
constexpr size_t WS_A0 = 264 * MiB;
constexpr size_t WS_A1 = WS_A0 + ACT;
constexpr size_t WS_A2 = WS_A1 + ACT;
constexpr size_t WS_A3 = WS_A2 + ACT;
constexpr size_t WS_G = WS_A0;
constexpr size_t WS_END = WS_A3 + ACT;
static_assert(WS_WT + 4 * WT_LAYER <= WS_XS && WS_XS + ACT <= WS_A0 && (size_t)MA * FF * 2 <= 3 * ACT, "d_ws map");

__device__ __forceinline__ unsigned pk2(float a, float b) { f32x2 v = {a, b}; return __builtin_bit_cast(unsigned, __builtin_convertvector(v, bf16v2)); }
__device__ __forceinline__ float bflo(unsigned u) { return __uint_as_float(u << 16); }
__device__ __forceinline__ float bfhi(unsigned u) { return __uint_as_float(u & 0xffff0000u); }
__device__ __forceinline__ float wave_sum(float v) {
#pragma unroll
    for (int o = 1; o < 64; o <<= 1) v += __shfl_xor(v, o);
    return v;
}
#define LDS_WAIT() asm volatile("s_waitcnt lgkmcnt(0)" ::: "memory")


struct EpiRes {
    static constexpr bool PERM = false, AFTER_DRAIN = false;
    const float* xin_l; const float* xin_c; float* xout_l; float* xout_c;
    const float* gate;
    const float* nrm;
    const float* nsc;
    bf16_t* xs; float* rss;
    __device__ __forceinline__ void operator()(const f32x4 (&acc)[2][2][4][2], const Unit& u, int wr, int wc, int fr, int fq) const {
        const bool lat = u.pm < 256; const int s = lat ? (u.pm >> 5) : 8;
        const size_t toff = (size_t)(lat ? u.pm : u.pm - 256) * 256 * D;
        const float* xi = (lat ? xin_l : xin_c) + toff; float* xo = (lat ? xout_l : xout_c) + toff;
        bf16_t* xsb = xs + (size_t)u.pm * 256 * D; float* rsb = rss + u.pm * 256;
        const float* gt = gate + s * 6144 + u.pn * 256; const float* nsp = nsc + s * 6144 + u.pn * 256; const float* nrp = nrm + u.pn * 256;
        const unsigned cl = wc * 32 + 4 * fq;
        const unsigned voff = (unsigned)(wr * 64 + fr) * D + u.pn * 256 + cl;
        float ss[2][4];
#pragma unroll
        for (int ai = 0; ai < 2; ++ai)
#pragma unroll
            for (int m = 0; m < 4; ++m) ss[ai][m] = 0.f;
#pragma unroll
        for (int bj = 0; bj < 2; ++bj)
#pragma unroll
            for (int n = 0; n < 2; ++n) { const int co = bj * 128 + n * 16;
                f32x4 xv[2][4];
                const f32x4 gv = *(const f32x4*)(gt + co + cl);
                f32x4 nv = (f32x4){0.f, 0.f, 0.f, 0.f}; if (nrm) nv = *(const f32x4*)(nrp + co + cl) * (*(const f32x4*)(nsp + co + cl) + 1.0f);
#pragma unroll
                for (int ai = 0; ai < 2; ++ai)
#pragma unroll
                    for (int m = 0; m < 4; ++m) xv[ai][m] = *(const f32x4*)(xi + (size_t)(ai * 128 + m * 16) * D + co + voff);
                asm volatile("" ::: "memory");
#pragma unroll
                for (int ai = 0; ai < 2; ++ai)
#pragma unroll
                    for (int m = 0; m < 4; ++m) { const size_t rb = (size_t)(ai * 128 + m * 16) * D + co;
                        const f32x4 x2 = xv[ai][m] + gv * acc[ai][bj][m][n]; *(f32x4*)(xo + rb + voff) = x2;
                        if (nrm) { ss[ai][m] += (x2[0] * x2[0] + x2[1] * x2[1]) + (x2[2] * x2[2] + x2[3] * x2[3]); const f32x4 y = x2 * nv; u32x2 w; w.x = pk2(y[0], y[1]); w.y = pk2(y[2], y[3]);
                            *(u32x2*)(xsb + rb + voff) = w; } }
                asm volatile("" ::: "memory");
            }
        if (nrm) {
#pragma unroll
            for (int ai = 0; ai < 2; ++ai)
#pragma unroll
                for (int m = 0; m < 4; ++m) { float t = ss[ai][m]; t += __shfl_xor(t, 16); t += __shfl_xor(t, 32); if (fq == 0) unsafeAtomicAdd(rsb + (ai * 128 + m * 16) + (wr * 64 + fr), t); } }
    }
};
struct EpiConvIn {
    static constexpr bool PERM = false, AFTER_DRAIN = false;
    const float* rss; const float* sW;
    bf16_t* BB; bf16_t* ZZ;
    __device__ __forceinline__ void operator()(const f32x4 (&acc)[2][2][4][2], const Unit& u, int wr, int wc, int fr, int fq) const {
        const int s = u.pm < 256 ? (u.pm >> 5) : 8; const float* sw = sW + s * 3072; const float* rsb = rss + u.pm * 256;
        const unsigned rl = wr * 64 + fr, cl = wc * 32 + 8 * fq;
        if (u.pn < 4) {
            asm volatile("" ::: "memory");
            const float* swb = sw + u.pn * 256; bf16_t* ob = BB + (size_t)u.pm * 256 * D + u.pn * 256; const unsigned voff = rl * D + cl;
            f32x4 sv[2][2];
#pragma unroll
            for (int bj = 0; bj < 2; ++bj)
#pragma unroll
                for (int n = 0; n < 2; ++n) sv[bj][n] = *(const f32x4*)(swb + bj * 128 + 4 * n + cl);
#pragma unroll
            for (int ai = 0; ai < 2; ++ai) { float rs4[4];
#pragma unroll
                for (int m = 0; m < 4; ++m) rs4[m] = rsqrtf(*(rsb + (ai * 128 + m * 16) + rl) * (1.0f / D) + EPS);
                asm volatile("" ::: "memory");
#pragma unroll
                for (int m = 0; m < 4; ++m) { const float rstd = rs4[m];
#pragma unroll
                    for (int bj = 0; bj < 2; ++bj) { const f32x4 v0 = acc[ai][bj][m][0] * rstd + sv[bj][0], v1 = acc[ai][bj][m][1] * rstd + sv[bj][1];
                        u32x4 w; w.x = pk2(v0[0], v0[1]); w.y = pk2(v0[2], v0[3]); w.z = pk2(v1[0], v1[1]); w.w = pk2(v1[2], v1[3]);
                        *(u32x4*)(ob + (size_t)(ai * 128 + m * 16) * D + bj * 128 + voff) = w; }
                    asm volatile("" ::: "memory"); } }
        } else {
            asm volatile("" ::: "memory");
            const float* swb = sw + (u.pn - 4) * 128; bf16_t* ob = ZZ + (size_t)u.pm * 256 * D + (u.pn - 4) * 128; const unsigned voff = rl * D + cl;
            f32x4 sc[2], su[2];
#pragma unroll
            for (int n = 0; n < 2; ++n) { sc[n] = *(const f32x4*)(swb + 1024 + 4 * n + cl); su[n] = *(const f32x4*)(swb + 2048 + 4 * n + cl); }
#pragma unroll
            for (int ai = 0; ai < 2; ++ai) { float rs4[4];
#pragma unroll
                for (int m = 0; m < 4; ++m) rs4[m] = rsqrtf(*(rsb + (ai * 128 + m * 16) + rl) * (1.0f / D) + EPS);
                asm volatile("" ::: "memory");
#pragma unroll
                for (int m = 0; m < 4; ++m) { const float rstd = rs4[m];
                    const f32x4 z0 = (acc[ai][0][m][0] * rstd + sc[0]) * (acc[ai][1][m][0] * rstd + su[0]), z1 = (acc[ai][0][m][1] * rstd + sc[1]) * (acc[ai][1][m][1] * rstd + su[1]);
                    u32x4 w; w.x = pk2(z0[0], z0[1]); w.y = pk2(z0[2], z0[3]); w.z = pk2(z1[0], z1[1]); w.w = pk2(z1[2], z1[3]);
                    *(u32x4*)(ob + (size_t)(ai * 128 + m * 16) * D + voff) = w;
                    asm volatile("" ::: "memory"); } }
        }
    }
};
struct EpiQKV {
    static constexpr bool PERM = false, AFTER_DRAIN = false;
    const float* rss; const float* sW; const float* gq; const float* gk; bf16_t* QKV;
    __device__ __forceinline__ void operator()(const f32x4 (&acc)[2][2][4][2], const Unit& u, int wr, int wc, int fr, int fq) const {
        const int s = u.pm < 256 ? (u.pm >> 5) : 8; const float* rsb = rss + u.pm * 256;
        const int part = u.pn >> 2, head = 4 * (u.pn & 3) + wc;
        const float* sw = sW + s * 3072 + 1024 * part + 64 * head;
        const float* gp = (part == 0 ? gq : gk); const float gs = part == 0 ? 0.125f * 1.4426950408889634f : 1.0f;
        bf16_t* ob = QKV + (size_t)part * (ACT / 2) + (size_t)u.pm * 256 * D + 64 * head;
        const unsigned rl = wr * 64 + fr, voff = rl * D + 8 * fq;
        float rstdv[2][4];
#pragma unroll
        for (int ai = 0; ai < 2; ++ai)
#pragma unroll
            for (int m = 0; m < 4; ++m) rstdv[ai][m] = rsqrtf(*(rsb + (ai * 128 + m * 16) + rl) * (1.0f / D) + EPS);
        asm volatile("" ::: "memory");
        f32x4 sv[2][2], gv[2][2];
#pragma unroll
        for (int bj = 0; bj < 2; ++bj)
#pragma unroll
            for (int n = 0; n < 2; ++n) { sv[bj][n] = *(const f32x4*)(sw + 32 * bj + 4 * n + 8 * fq); gv[bj][n] = *(const f32x4*)(gp + 32 * bj + 4 * n + 8 * fq) * gs; }
#pragma unroll
        for (int ai = 0; ai < 2; ++ai)
#pragma unroll
            for (int m = 0; m < 4; ++m) { const float rstd = rstdv[ai][m];
                f32x4 v00 = acc[ai][0][m][0] * rstd + sv[0][0], v01 = acc[ai][0][m][1] * rstd + sv[0][1], v10 = acc[ai][1][m][0] * rstd + sv[1][0], v11 = acc[ai][1][m][1] * rstd + sv[1][1];
                if (part < 2) { float ss = ((v00[0] * v00[0] + v00[1] * v00[1]) + (v00[2] * v00[2] + v00[3] * v00[3])) + ((v01[0] * v01[0] + v01[1] * v01[1]) + (v01[2] * v01[2] + v01[3] * v01[3]))
                                         + ((v10[0] * v10[0] + v10[1] * v10[1]) + (v10[2] * v10[2] + v10[3] * v10[3])) + ((v11[0] * v11[0] + v11[1] * v11[1]) + (v11[2] * v11[2] + v11[3] * v11[3]));
                    ss += __shfl_xor(ss, 16); ss += __shfl_xor(ss, 32); const float r = rsqrtf(ss * (1.0f / HD) + EPS);
                    v00 = v00 * r * gv[0][0]; v01 = v01 * r * gv[0][1]; v10 = v10 * r * gv[1][0]; v11 = v11 * r * gv[1][1]; }
                bf16_t* orow = ob + (size_t)(ai * 128 + m * 16) * D;
                { u32x4 w; w.x = pk2(v00[0], v00[1]); w.y = pk2(v00[2], v00[3]); w.z = pk2(v01[0], v01[1]); w.w = pk2(v01[2], v01[3]); *(u32x4*)(orow + voff) = w; }
                { u32x4 w; w.x = pk2(v10[0], v10[1]); w.y = pk2(v10[2], v10[3]); w.z = pk2(v11[0], v11[1]); w.w = pk2(v11[2], v11[3]); *(u32x4*)(orow + 32 + voff) = w; } }
    }
};
struct EpiSwi {
    static constexpr bool PERM = false, AFTER_DRAIN = false;
    const float* rss; const float* sW;
    bf16_t* G;
    __device__ __forceinline__ void operator()(const f32x4 (&acc)[2][2][4][2], const Unit& u, int wr, int wc, int fr, int fq) const {
        const int s = u.pm < 256 ? (u.pm >> 5) : 8; const float* swb = sW + s * (2 * FF) + u.pn * 128; const float* rsb = rss + u.pm * 256;
        bf16_t* ob = G + (size_t)u.pm * 256 * FF + u.pn * 128;
        const unsigned rl = wr * 64 + fr, cl = wc * 32 + 8 * fq, voff = rl * FF + cl;
        float rstdv[2][4];
#pragma unroll
        for (int ai = 0; ai < 2; ++ai)
#pragma unroll
            for (int m = 0; m < 4; ++m) rstdv[ai][m] = rsqrtf(*(rsb + (ai * 128 + m * 16) + rl) * (1.0f / D) + EPS);
        asm volatile("" ::: "memory");
        f32x4 sg[2], su[2];
#pragma unroll
        for (int n = 0; n < 2; ++n) { sg[n] = *(const f32x4*)(swb + 4 * n + cl); su[n] = *(const f32x4*)(swb + FF + 4 * n + cl); }
#pragma unroll
        for (int ai = 0; ai < 2; ++ai)
#pragma unroll
            for (int m = 0; m < 4; ++m) { const float rstd = rstdv[ai][m];
                f32x4 o[2];
#pragma unroll
                for (int n = 0; n < 2; ++n) { const f32x4 g = acc[ai][0][m][n] * rstd + sg[n], up = acc[ai][1][m][n] * rstd + su[n];
#pragma unroll
                    for (int e = 0; e < 4; ++e) o[n][e] = g[e] * __builtin_amdgcn_rcpf(1.0f + __builtin_amdgcn_exp2f(g[e] * -1.4426950408889634f)) * up[e]; }
                u32x4 w; w.x = pk2(o[0][0], o[0][1]); w.y = pk2(o[0][2], o[0][3]); w.z = pk2(o[1][0], o[1][1]); w.w = pk2(o[1][2], o[1][3]);
                *(u32x4*)(ob + (size_t)(ai * 128 + m * 16) * FF + voff) = w; }
    }
};

__device__ __forceinline__ void gemv9_task(LAS float* vl, LAS float* red, const float* W, int ldw, int col0, float* out, int ostride, const float* bias) {
    const int tid = threadIdx.x, lane = tid & 63, w = tid >> 6;
    float a[NS][2];
#pragma unroll
    for (int s = 0; s < NS; ++s) { a[s][0] = 0.f; a[s][1] = 0.f; }
    const float* wp = W + (size_t)(128 * w) * ldw + col0 + 2 * lane;
#pragma unroll 8
    for (int kk = 0; kk < 128; ++kk) {
        const f32x2 wv = *(const f32x2*)(wp + (size_t)kk * ldw);
        const LAS f32x4* v = (const LAS f32x4*)(vl + (128 * w + kk) * 12);
        const f32x4 v0 = v[0], v1 = v[1], v2 = v[2];
        a[0][0] += v0[0] * wv[0]; a[0][1] += v0[0] * wv[1]; a[1][0] += v0[1] * wv[0]; a[1][1] += v0[1] * wv[1];
        a[2][0] += v0[2] * wv[0]; a[2][1] += v0[2] * wv[1]; a[3][0] += v0[3] * wv[0]; a[3][1] += v0[3] * wv[1];
        a[4][0] += v1[0] * wv[0]; a[4][1] += v1[0] * wv[1]; a[5][0] += v1[1] * wv[0]; a[5][1] += v1[1] * wv[1];
        a[6][0] += v1[2] * wv[0]; a[6][1] += v1[2] * wv[1]; a[7][0] += v1[3] * wv[0]; a[7][1] += v1[3] * wv[1];
        a[8][0] += v2[0] * wv[0]; a[8][1] += v2[0] * wv[1];
    }
#pragma unroll
    for (int s = 0; s < NS; ++s) { red[(w * NS + s) * 128 + 2 * lane] = a[s][0]; red[(w * NS + s) * 128 + 2 * lane + 1] = a[s][1]; }
    __syncthreads();
    for (int idx = tid; idx < NS * 128; idx += NTHR) { const int s = idx >> 7, c = idx & 127; float t = bias ? bias[col0 + c] : 0.f;
#pragma unroll
        for (int ww = 0; ww < NWAVE; ++ww) t += red[(ww * NS + s) * 128 + c];
        out[(size_t)s * ostride + col0 + c] = t; }
    __syncthreads();
}

__device__ __forceinline__ void transpose_item(const float* W, int K, int N, bf16_t* WT, int src0, int nrow0, bool perm, int k0, LAS float* scr, int lane) {
#pragma unroll
    for (int i = 0; i < 32; ++i) { const int kk = 2 * i + (lane >> 5); scr[kk * 33 + (lane & 31)] = W[(size_t)(k0 + kk) * N + src0 + (lane & 31)]; }
    LDS_WAIT(); asm volatile("" ::: "memory");
    const int c = lane & 7;
#pragma unroll
    for (int j = 0; j < 4; ++j) { const int nl = (lane >> 3) + 8 * j; const int pc = perm ? pg8::perm32(nl) : nl; const LAS float* s = scr + (8 * c) * 33 + pc;
        u32x4 o; o.x = pk2(s[0 * 33], s[1 * 33]); o.y = pk2(s[2 * 33], s[3 * 33]); o.z = pk2(s[4 * 33], s[5 * 33]); o.w = pk2(s[6 * 33], s[7 * 33]);
        *(u32x4*)(WT + (size_t)(nrow0 + nl) * K + k0 + 8 * c) = o; }
    LDS_WAIT(); asm volatile("" ::: "memory");
}

struct Params { const float* in[18]; float* out; unsigned char* ws; };
enum { I_X = 0, I_C, I_CTX, I_CCTX, I_WADA, I_BADA, I_NMIX, I_NFFN, I_CWIN, I_CW, I_CWOUT, I_AQKV, I_AQN, I_AKN, I_ARPB, I_AWOUT, I_FWIN, I_FWOUT };

__device__ __forceinline__ void conv_phase(const bf16_t* BB, const bf16_t* ZZ, bf16_t* A3, const float* cw, int gw_, int ngw, int lane_) {
    int lane = lane_, gw = gw_; asm volatile("" : "+v"(lane), "+s"(gw));
    constexpr int CH = 33; constexpr int NT = MA / CH; static_assert(NT * CH == MA, "conv chunks");
    f32x4 w0[4], w1[4], w2[4];
#pragma unroll
    for (int q = 0; q < 4; ++q) { w0[q] = *(const f32x4*)(cw + 16 * lane + 4 * q); w1[q] = *(const f32x4*)(cw + D + 16 * lane + 4 * q); w2[q] = *(const f32x4*)(cw + 2 * D + 16 * lane + 4 * q); }
    for (int task = gw; task < NT; task += ngw) {
        const int g0 = task * CH;
        const u32x4 zero = {0u, 0u, 0u, 0u};
        u32x4 zp[2], zc[2], nz[3][2], nb[3][2];
        { const u32x4* p = (const u32x4*)(ZZ + (size_t)g0 * D + 16 * lane); zc[0] = p[0]; zc[1] = p[1]; }
        if (g0 > 0) { const u32x4* p = (const u32x4*)(ZZ + (size_t)(g0 - 1) * D + 16 * lane); zp[0] = p[0]; zp[1] = p[1]; } else { zp[0] = zero; zp[1] = zero; }
#pragma unroll
        for (int k = 0; k < 3; ++k) { const int g = g0 + k;
            if (g + 1 < MA) { const u32x4* p = (const u32x4*)(ZZ + (size_t)(g + 1) * D + 16 * lane); nz[k][0] = p[0]; nz[k][1] = p[1]; } else { nz[k][0] = zero; nz[k][1] = zero; }
            { const u32x4* p = (const u32x4*)(BB + (size_t)g * D + 16 * lane); nb[k][0] = p[0]; nb[k][1] = p[1]; } }
        for (int grp = 0; grp < CH / 3; ++grp) {
            u32x4 pz[3][2], pb[3][2];
#pragma unroll
            for (int k = 0; k < 3; ++k) { const int g = g0 + 3 * (grp + 1) + k;
                if (grp + 1 < CH / 3) {
                    if (g + 1 < MA) { const u32x4* p = (const u32x4*)(ZZ + (size_t)(g + 1) * D + 16 * lane); pz[k][0] = p[0]; pz[k][1] = p[1]; } else { pz[k][0] = zero; pz[k][1] = zero; }
                    { const u32x4* p = (const u32x4*)(BB + (size_t)g * D + 16 * lane); pb[k][0] = p[0]; pb[k][1] = p[1]; } }
                else { pz[k][0] = zero; pz[k][1] = zero; pb[k][0] = zero; pb[k][1] = zero; } }
#pragma unroll
            for (int k = 0; k < 3; ++k) {
                const int g = g0 + 3 * grp + k;
                const int pos = g < ML ? (g & (SEQ - 1)) : ((g - ML) & (CTX - 1)); const int L = g < ML ? SEQ : CTX;
                const float mp = pos > 0 ? 1.f : 0.f, mn = pos < L - 1 ? 1.f : 0.f;
                u32x4 ov[2];
#pragma unroll
                for (int hh = 0; hh < 2; ++hh)
#pragma unroll
                    for (int q = 0; q < 4; ++q) { const int wq = hh * 2 + (q >> 1), e0 = (q & 1) * 2;
                        const float lo = bflo(nb[k][hh][q]) * (w0[wq][e0] * mp * bflo(zp[hh][q]) + w1[wq][e0] * bflo(zc[hh][q]) + w2[wq][e0] * mn * bflo(nz[k][hh][q]));
                        const float hi = bfhi(nb[k][hh][q]) * (w0[wq][e0 + 1] * mp * bfhi(zp[hh][q]) + w1[wq][e0 + 1] * bfhi(zc[hh][q]) + w2[wq][e0 + 1] * mn * bfhi(nz[k][hh][q]));
                        ov[hh][q] = pk2(lo, hi); }
                { u32x4* p = (u32x4*)(A3 + (size_t)g * D + 16 * lane); p[0] = ov[0]; p[1] = ov[1]; }
                zp[0] = zc[0]; zp[1] = zc[1]; zc[0] = nz[k][0]; zc[1] = nz[k][1];
            }
#pragma unroll
            for (int k = 0; k < 3; ++k) { nz[k][0] = pz[k][0]; nz[k][1] = pz[k][1]; nb[k][0] = pb[k][0]; nb[k][1] = pb[k][1]; }
        }
    }
}

constexpr int KT_SZ = 64 * 144, VT_PITCH = 192, VT_SZ = 64 * VT_PITCH, AT_KT = 0, AT_VT = 2 * KT_SZ, AT_RPB = AT_VT + 2 * VT_SZ;
constexpr float LOG2E = 1.4426950408889634f;
__device__ __forceinline__ int rstart(int r) { return min(max(r - 4, 0), SEQ / GW - 8); }
#define MFMA32(a, b, c) __builtin_amdgcn_mfma_f32_32x32x16_bf16((a), (b), (c), 0, 0, 0)
typedef short s16x4 __attribute__((ext_vector_type(4)));
__device__ __forceinline__ bf16x8 vt_frag(const LAS unsigned char* vlane, int off) {
    const s16x4 lo = __builtin_amdgcn_ds_read_tr16_b64_v4i16((LAS s16x4*)(vlane + off)), hi2 = __builtin_amdgcn_ds_read_tr16_b64_v4i16((LAS s16x4*)(vlane + off + 8 * VT_PITCH));
    return __builtin_shufflevector(lo, hi2, 0, 1, 2, 3, 4, 5, 6, 7);
}
__device__ __forceinline__ const LAS unsigned char* vt_lane(const LAS unsigned char* vt, int l31, int hi) { return vt + (4 * hi + ((l31 >> 2) & 3)) * VT_PITCH + (16 * ((l31 >> 4) & 1) + 4 * (l31 & 3)) * 2; }
template <int MODE>
__device__ __forceinline__ void attn_tile(const LAS unsigned char* kt, const LAS unsigned char* vt, const LAS float* rpl, int wcs, const bf16x8 (&qf)[4], int l31, int hi, f32x16& o0, f32x16& o1, f32x16& lacc) {
    bf16x8 kf[2][4];
#pragma unroll
    for (int kb2 = 0; kb2 < 2; ++kb2)
#pragma unroll
        for (int s = 0; s < 4; ++s) kf[kb2][s] = *(const LAS bf16x8*)(kt + (32 * kb2 + l31) * 144 + (16 * s + 8 * hi) * 2);
    float bias[2][16];
#pragma unroll
    for (int kb2 = 0; kb2 < 2; ++kb2)
#pragma unroll
        for (int i = 0; i < 16; ++i) { const bool live = MODE != 0 && (MODE == 1 ? (kb2 == 0 || i < 4) : (kb2 == 1 || i >= 12)); bias[kb2][i] = live ? rpl[32 * kb2 + (i & 3) + 8 * (i >> 2)] : 0.f; }
    __builtin_amdgcn_sched_barrier(0);
    f32x16 st[2];
#pragma unroll
    for (int kb2 = 0; kb2 < 2; ++kb2) {
#pragma unroll
        for (int i = 0; i < 16; ++i) st[kb2][i] = 0.f;
    }
    __builtin_amdgcn_s_setprio(1);
#pragma unroll
    for (int s = 0; s < 4; ++s) { st[0] = MFMA32(kf[0][s], qf[s], st[0]); st[1] = MFMA32(kf[1][s], qf[s], st[1]); }
    __builtin_amdgcn_s_setprio(0);
    const LAS unsigned char* vl = vt_lane(vt, l31, hi);
    bf16x8 vf0[2][2], vf1[2][2];
#pragma unroll
    for (int kb2 = 0; kb2 < 2; ++kb2)
#pragma unroll
        for (int t = 0; t < 2; ++t) { const bool livestep = MODE == 0 || (MODE == 1 ? !(kb2 == 1 && t == 1) : !(kb2 == 0 && t == 0));
            if (livestep) { const int ko = (32 * kb2 + 16 * t) * VT_PITCH; vf0[kb2][t] = vt_frag(vl, ko); vf1[kb2][t] = vt_frag(vl, ko + 64); }
            else { vf0[kb2][t] = kf[0][0]; vf1[kb2][t] = kf[0][0]; } }
    __builtin_amdgcn_sched_barrier(0);
#pragma unroll
    for (int kb2 = 0; kb2 < 2; ++kb2)
#pragma unroll
        for (int i = 0; i < 16; ++i) {
            const int kcc = 32 * kb2 + (i & 3) + 8 * (i >> 2);
            const bool live = MODE == 0 || (MODE == 1 ? (kb2 == 0 || i < 4) : (kb2 == 1 || i >= 12));
            if (!live) { st[kb2][i] = 0.f; continue; }
            if (MODE == 0) st[kb2][i] = __builtin_amdgcn_exp2f(st[kb2][i]);
            else { const bool valid = (unsigned)(kcc - wcs) < 16u; const float pe = __builtin_amdgcn_exp2f(st[kb2][i] + bias[kb2][i]); st[kb2][i] = valid ? pe : 0.f; }
        }
    u32x4 onesw; onesw.x = 0x3f803f80u; onesw.y = 0x3f803f80u; onesw.z = 0x3f803f80u; onesw.w = 0x3f803f80u;
    const bf16x8 ones = __builtin_bit_cast(bf16x8, onesw);
#pragma unroll
    for (int kb2 = 0; kb2 < 2; ++kb2)
#pragma unroll
        for (int t = 0; t < 2; ++t) {
            const bool livestep = MODE == 0 || (MODE == 1 ? !(kb2 == 1 && t == 1) : !(kb2 == 0 && t == 0));
            if (!livestep) continue;
            u32x4 pw; pw.x = pk2(st[kb2][8 * t + 0], st[kb2][8 * t + 1]); pw.y = pk2(st[kb2][8 * t + 2], st[kb2][8 * t + 3]); pw.z = pk2(st[kb2][8 * t + 4], st[kb2][8 * t + 5]); pw.w = pk2(st[kb2][8 * t + 6], st[kb2][8 * t + 7]);
            const bf16x8 pf = __builtin_bit_cast(bf16x8, pw);
            __builtin_amdgcn_s_setprio(1);
            o0 = MFMA32(vf0[kb2][t], pf, o0);
            o1 = MFMA32(vf1[kb2][t], pf, o1);
            lacc = MFMA32(ones, pf, lacc);
            __builtin_amdgcn_s_setprio(0);
        }
}
__device__ __forceinline__ void attn_wtile(const LAS unsigned char* kt, const LAS unsigned char* vt, const LAS float* rpl, int wcsr, int kb0, const bf16x8 (&qf)[4], int l31, int hi, f32x16& o0, f32x16& o1, f32x16& lacc) {
    bf16x8 kf[4];
#pragma unroll
    for (int s = 0; s < 4; ++s) kf[s] = *(const LAS bf16x8*)(kt + (kb0 + l31) * 144 + (16 * s + 8 * hi) * 2);
    float bias[16];
#pragma unroll
    for (int i = 0; i < 16; ++i) bias[i] = rpl[(i & 3) + 8 * (i >> 2)];
    __builtin_amdgcn_sched_barrier(0);
    f32x16 st;
#pragma unroll
    for (int i = 0; i < 16; ++i) st[i] = 0.f;
    __builtin_amdgcn_s_setprio(1);
#pragma unroll
    for (int s = 0; s < 4; ++s) st = MFMA32(kf[s], qf[s], st);
    __builtin_amdgcn_s_setprio(0);
    bf16x8 vf0[2], vf1[2];
    const LAS unsigned char* vl = vt_lane(vt, l31, hi);
#pragma unroll
    for (int t = 0; t < 2; ++t) { const int ko = (kb0 + 16 * t) * VT_PITCH; vf0[t] = vt_frag(vl, ko); vf1[t] = vt_frag(vl, ko + 64); }
    __builtin_amdgcn_sched_barrier(0);
#pragma unroll
    for (int i = 0; i < 16; ++i) { const int kcc = (i & 3) + 8 * (i >> 2); const bool valid = (unsigned)(kcc - wcsr) < 16u; const float pe = __builtin_amdgcn_exp2f(st[i] + bias[i]); st[i] = valid ? pe : 0.f; }
    u32x4 onesw; onesw.x = 0x3f803f80u; onesw.y = 0x3f803f80u; onesw.z = 0x3f803f80u; onesw.w = 0x3f803f80u;
    const bf16x8 ones = __builtin_bit_cast(bf16x8, onesw);
#pragma unroll
    for (int t = 0; t < 2; ++t) {
        u32x4 pw; pw.x = pk2(st[8 * t + 0], st[8 * t + 1]); pw.y = pk2(st[8 * t + 2], st[8 * t + 3]); pw.z = pk2(st[8 * t + 4], st[8 * t + 5]); pw.w = pk2(st[8 * t + 6], st[8 * t + 7]);
        const bf16x8 pf = __builtin_bit_cast(bf16x8, pw);
        __builtin_amdgcn_s_setprio(1);
        o0 = MFMA32(vf0[t], pf, o0);
        o1 = MFMA32(vf1[t], pf, o1);
        lacc = MFMA32(ones, pf, lacc);
        __builtin_amdgcn_s_setprio(0);
    }
}
__device__ __forceinline__ void attn_phase(LAS unsigned char* lds, const bf16_t* Q, const bf16_t* K, const bf16_t* V, bf16_t* O, const float* rpb, bool ctxq, int bid, int G, int revimg) {
    int tid_ = threadIdx.x; asm volatile("" : "+v"(tid_));
    const int tid = tid_, lane = tid & 63, w = __builtin_amdgcn_readfirstlane(tid >> 6), hi = lane >> 5, l31 = lane & 31;
    LAS float* rp = (LAS float*)(lds + AT_RPB);
    const int srow = tid >> 3, sch = tid & 7;
    const int nlat = NB * NH * 32;
    const int nun = nlat + (ctxq ? NB * NH : 0);
    const bool xmap = (G == 256);
    for (int it = 0; ; ++it) {
        int un = bid + it * G;
        if (un >= nun) break;
        const bool isctx = un >= nlat;
        int b, h, rq = 0, nwin = 0, kr_lo = 0, r_w = 0, rs_w = 0, qc = 0, r0 = 0, rs_lo = 0, rs_hi = 0, kb0 = 0; size_t tq;
        if (!isctx) {
            if (xmap) { int img = (bid & 7) + 8 * it; if (revimg) img = NB * NH - 1 - img; rq = bid >> 3; h = img & 15; b = img >> 4; }
            else { rq = un & 31; h = (un >> 5) & 15; b = un >> 9; }
            kr_lo = rstart(4 * rq); nwin = rstart(4 * rq + 3) + 8 - kr_lo;
            r0 = 4 * rq + 2 * (w >> 2); r_w = r0 + ((l31 >> 4) & 1); rs_w = rstart(r_w); qc = 16 * (w & 3) + (l31 & 15);
            rs_lo = rstart(r0); rs_hi = rstart(r0 + 1) + 8; kb0 = min(max(16 * (w & 3) - 8, 0), 32);
            tq = (size_t)b * SEQ + r_w * GW + qc; }
        else { const int v = un - nlat; h = v & 15; b = v >> 4; tq = (size_t)ML + b * CTX + 32 * w + l31; }
        const int T = nwin + 4;
        const int cs = min(max(qc - 8, 0), GW - 16);
        const int wcs = cs - kb0 - 4 * hi;
        bf16x8 qf[4];
        { const bf16_t* qp = Q + tq * D + 64 * h + 8 * hi;
#pragma unroll
          for (int s = 0; s < 4; ++s) qf[s] = *(const bf16x8*)(qp + 16 * s); }
        if (!isctx) for (int i = tid; i < 465; i += NTHR) rp[i] = rpb[h * 465 + i] * LOG2E;
        f32x16 o0, o1, lacc;
#pragma unroll
        for (int i = 0; i < 16; ++i) { o0[i] = 0.f; o1[i] = 0.f; lacc[i] = 0.f; }
        const size_t ctxbase = (size_t)ML + b * CTX, latbase = (size_t)b * SEQ;
        const size_t coloff = (size_t)srow * D + 64 * h + 8 * sch;
#define AT_TILE_OFF(jj) ((((jj) < nwin) ? latbase + (size_t)(kr_lo + (jj)) * GW : ctxbase + 64 * ((jj) - nwin)) * D + coloff)
#define AT_LOAD(kr_, vr_, jj) do { const size_t off_ = AT_TILE_OFF(jj); kr_ = *(const u32x4*)(K + off_); vr_ = *(const u32x4*)(V + off_); } while (0)
#define AT_WRITE(kr_, vr_, bufi) do { LAS unsigned char* kt_ = lds + AT_KT + (bufi) * KT_SZ; LAS unsigned char* vt_ = lds + AT_VT + (bufi) * VT_SZ; \
            *(LAS u32x4*)(kt_ + srow * 144 + sch * 16) = kr_; *(LAS u32x4*)(vt_ + srow * VT_PITCH + sch * 16) = vr_; } while (0)
#define AT_COMPUTE(jj, bufi) do { const LAS unsigned char* kt_ = lds + AT_KT + (bufi) * KT_SZ; const LAS unsigned char* vt_ = lds + AT_VT + (bufi) * VT_SZ; const int kr_ = kr_lo + (jj); \
            if ((jj) >= nwin) attn_tile<0>(kt_, vt_, rp, 0, qf, l31, hi, o0, o1, lacc); \
            else if (kr_ >= rs_lo && kr_ < rs_hi) { const LAS float* rpl_ = rp + ((kr_ - r_w + 7) * 31 + 15 - qc + kb0 + 4 * hi); \
                const int wcsr_ = ((unsigned)(kr_ - rs_w) < 8u) ? wcs : 4096;     \
                attn_wtile(kt_, vt_, rpl_, wcsr_, kb0, qf, l31, hi, o0, o1, lacc); } } while (0)
        u32x4 k0r, v0r, k1r, v1r;
        AT_LOAD(k0r, v0r, 0); AT_LOAD(k1r, v1r, 1);
        AT_WRITE(k0r, v0r, 0);
        __syncthreads();
        int j = 0;
        for (; j + 1 < T; j += 2) {
            { const int jl = min(j + 2, T - 1); AT_LOAD(k0r, v0r, jl); }
            AT_COMPUTE(j, 0);
            AT_WRITE(k1r, v1r, 1);
            __syncthreads();
            { const int jl = min(j + 3, T - 1); AT_LOAD(k1r, v1r, jl); }
            AT_COMPUTE(j + 1, 1);
            AT_WRITE(k0r, v0r, 0);
            __syncthreads();
        }
        if (j < T) { AT_COMPUTE(j, 0); __syncthreads(); }
#undef AT_TILE_OFF
#undef AT_LOAD
#undef AT_WRITE
#undef AT_COMPUTE
        const float inv = 1.0f / lacc[0];
        bf16_t* op = O + tq * D + 64 * h + 4 * hi;
#pragma unroll
        for (int g = 0; g < 4; ++g) { u32x2 wv; wv.x = pk2(o0[4 * g] * inv, o0[4 * g + 1] * inv); wv.y = pk2(o0[4 * g + 2] * inv, o0[4 * g + 3] * inv); *(u32x2*)(op + 8 * g) = wv;
            u32x2 wv1; wv1.x = pk2(o1[4 * g] * inv, o1[4 * g + 1] * inv); wv1.y = pk2(o1[4 * g + 2] * inv, o1[4 * g + 3] * inv); *(u32x2*)(op + 32 + 8 * g) = wv1; }
    }
}

#define XB_TMO      128
#define XB_XCNT(j)  (256  + 64 * (j))
#define XB_XSUB(j)  (1280 + 64 * (j))
#define XB_XGEN(j)  (2304 + 64 * (j))
#define XB_TOP      3328
#define XB_TOPGEN   3392
#define XCD_BAR_WORDS 3456
#define XB_SPIN_CAP (1u << 18)

__device__ __forceinline__ unsigned xb_ld(unsigned* p)              { return __hip_atomic_load(p, __ATOMIC_RELAXED, __HIP_MEMORY_SCOPE_AGENT); }
__device__ __forceinline__ unsigned xb_add(unsigned* p, unsigned v) { return __hip_atomic_fetch_add(p, v, __ATOMIC_RELAXED, __HIP_MEMORY_SCOPE_AGENT); }
__device__ __forceinline__ unsigned xb_xcc_id() { return (unsigned)__builtin_amdgcn_s_getreg((3 << 11) | 20) & 0xFu; }
#define XB_SPIN(cond, bar) do { unsigned _sp = 0; while (cond) { __builtin_amdgcn_s_sleep(1); \
    if ((++_sp & 255u) == 0u) { if (xb_ld(&(bar)[XB_TMO])) break; if (_sp > XB_SPIN_CAP) { atomicAdd(&(bar)[XB_TMO], 1u); break; } } } } while (0)

struct XcdBarrier {
    unsigned* bar; unsigned x;
    volatile LAS unsigned* st;
};

__device__ __forceinline__ XcdBarrier xcd_barrier_post(unsigned* bar, volatile LAS unsigned* st) {
    XcdBarrier b; b.bar = bar; b.x = xb_xcc_id(); b.st = st;
    if (threadIdx.x == 0) (void)xb_add(&bar[XB_XCNT(b.x)], 1u);
    return b;
}
__device__ __forceinline__ void xcd_barrier_complete(unsigned* bar, unsigned x, unsigned& nloc, unsigned& nx) {
    const unsigned G = gridDim.x * gridDim.y * gridDim.z;
    unsigned sum, cnt, mine, sp = 0u;
    for (;;) {
        sum = 0u; cnt = 0u; mine = 0u;
#pragma unroll
        for (unsigned j = 0; j < 16; ++j) { const unsigned c = xb_ld(&bar[XB_XCNT(j)]); sum += c; cnt += (c > 0u) ? 1u : 0u; mine = (j == x) ? c : mine; }
        if (sum == G) break;
        __builtin_amdgcn_s_sleep(1);
        if ((++sp & 255u) == 0u) { if (xb_ld(&bar[XB_TMO])) break; if (sp > XB_SPIN_CAP) { atomicAdd(&bar[XB_TMO], 1u); break; } }
    }
    nloc = mine > 0u ? mine : 1u; nx = cnt > 0u ? cnt : 1u;
}

__device__ __forceinline__ void xcd_barrier(const XcdBarrier& b) {
    asm volatile("s_waitcnt vmcnt(0)" ::: "memory");
    __syncthreads();
    if (threadIdx.x == 0) {
        unsigned* bar = b.bar;
        __builtin_amdgcn_s_waitcnt(0);
        unsigned nloc = b.st[0], nx = b.st[1];
        if (nloc == 0u) { xcd_barrier_complete(bar, b.x, nloc, nx); b.st[0] = nloc; b.st[1] = nx; }
        const unsigned old = xb_add(&bar[XB_XSUB(b.x)], 1u);
        const unsigned gen = old / nloc;
        if (old + 1u == (gen + 1u) * nloc) {
            __builtin_amdgcn_fence(__ATOMIC_RELEASE, "agent");
            asm volatile("s_waitcnt vmcnt(0)" ::: "memory");
            const unsigned og = xb_add(&bar[XB_TOP], 1u);
            const unsigned tg = og / nx;
            if (og + 1u == (tg + 1u) * nx) xb_add(&bar[XB_TOPGEN], 1u);
            else XB_SPIN(xb_ld(&bar[XB_TOPGEN]) == tg, bar);
            __builtin_amdgcn_fence(__ATOMIC_ACQUIRE, "agent");
            xb_add(&bar[XB_XGEN(b.x)], 1u);
            asm volatile("s_waitcnt vmcnt(0)" ::: "memory");
        } else {
            XB_SPIN(xb_ld(&bar[XB_XGEN(b.x)]) == gen, bar);
            __builtin_amdgcn_fence(__ATOMIC_ACQUIRE, "agent");
            asm volatile("s_waitcnt vmcnt(0)" ::: "memory");
        }
    }
    __syncthreads();
}

#ifndef REV_G1
#define REV_G1 1
#define REV_G2 0
#define REV_F1 1
#define REV_F2 0
#endif
#ifdef PROBE_SYNC2
#define GSYNC() do { xcd_barrier(xbar); xcd_barrier(xbar); } while (0)
#else
#define GSYNC() xcd_barrier(xbar)
#endif
__global__ void __launch_bounds__(NTHR, 2) mega_fwd(Params P) {
    extern __shared__ __attribute__((aligned(16))) unsigned char lds_raw[];
    LAS unsigned char* lds = (LAS unsigned char*)lds_raw;
    cg::grid_group grid = cg::this_grid();
    const int tid = threadIdx.x, lane = tid & 63, wave = __builtin_amdgcn_readfirstlane(tid >> 6);
    const int G = gridDim.x, bid = blockIdx.x;
    const int gw = bid * NWAVE + wave, ngw = G * NWAVE;
    unsigned char* ws = P.ws;
    volatile LAS unsigned* xst = (volatile LAS unsigned*)(lds + 131072);
    if (tid < 2) xst[tid] = 0u;
    __syncthreads();
    const XcdBarrier xbar = xcd_barrier_post((unsigned*)(ws + WS_BAR), xst);
    float* MOD = (float*)(ws + WS_MOD); float* SWM = (float*)(ws + WS_SWM); float* SWF = (float*)(ws + WS_SWF); float* RSS = (float*)(ws + WS_RSS); float* XC = (float*)(ws + WS_XC);
    bf16_t* XS = (bf16_t*)(ws + WS_XS); bf16_t* A0 = (bf16_t*)(ws + WS_A0); bf16_t* A1 = (bf16_t*)(ws + WS_A1); bf16_t* A2 = (bf16_t*)(ws + WS_A2); bf16_t* A3 = (bf16_t*)(ws + WS_A3); bf16_t* GG = (bf16_t*)(ws + WS_G);

#ifdef PROBE_PRO2
    for (int rep_ = 0; rep_ < 2; ++rep_) { if (rep_) GSYNC();
#endif
    {
        LAS float* vl = (LAS float*)lds; LAS float* red = (LAS float*)(lds + 49152);
        for (int idx = tid; idx < NS * D; idx += NTHR) { const int s = idx >> 10, k = idx & 1023; const float c = s < 8 ? P.in[I_C][s * D + k] : P.in[I_CCTX][k]; vl[k * 12 + s] = c / (1.0f + __expf(-c)); }
        __syncthreads();
        for (int task = bid; task < DEPTH * 48; task += G) { const int i = task / 48, cc = task % 48;
            gemv9_task(vl, red, P.in[I_WADA] + (size_t)i * D * 6144, 6144, cc * 128, MOD + (size_t)i * NS * 6144, 6144, P.in[I_BADA] + i * 6144); }
        for (int idx = bid * NTHR + tid; idx < 8 * MA; idx += G * NTHR) RSS[idx] = 0.f;
        __syncthreads();
        LAS float* scr = (LAS float*)(lds + wave * 16384);
        constexpr int IT_MIXIN = 16 * 96, IT_MIXOUT = 16 * 32, IT_FFNIN = 16 * 176, IT_FFNOUT = 44 * 32, IT_LAYER = IT_MIXIN + IT_MIXOUT + IT_FFNIN + IT_FFNOUT;
        for (int it = gw; it < DEPTH * IT_LAYER; it += ngw) {
            const int i = it / IT_LAYER; int r = it % IT_LAYER; const int j = i >> 1; const bool conv = (i & 1) == 0;
            unsigned char* wt = ws + WS_WT + (size_t)i * WT_LAYER;
            if (r < IT_MIXIN) { const int kb = r / 96, g = r % 96, pn = g >> 3, bj = (g >> 2) & 1, wc = g & 3;
                const int src0 = conv ? (pn < 4 ? 256 * pn + 128 * bj + 32 * wc : 1024 * (1 + bj) + 128 * (pn - 4) + 32 * wc) : (1024 * (pn >> 2) + 64 * (4 * (pn & 3) + wc) + 32 * bj);
                const float* W = conv ? P.in[I_CWIN] + (size_t)j * D * 3072 : P.in[I_AQKV] + (size_t)j * D * 3072;
                transpose_item(W, D, 3072, (bf16_t*)(wt + WT_MIXIN), src0, 32 * g, true, 64 * kb, scr, lane); continue; }
            r -= IT_MIXIN;
            if (r < IT_MIXOUT) { const int kb = r / 32, g = r % 32; const float* W = conv ? P.in[I_CWOUT] + (size_t)j * D * D : P.in[I_AWOUT] + (size_t)j * D * D;
                transpose_item(W, D, D, (bf16_t*)(wt + WT_MIXOUT), 32 * g, 32 * g, false, 64 * kb, scr, lane); continue; }
            r -= IT_MIXOUT;
            if (r < IT_FFNIN) { const int kb = r / 176, g = r % 176, pn = g >> 3, bj = (g >> 2) & 1, wc = g & 3; const int src0 = FF * bj + 128 * pn + 32 * wc;
                transpose_item(P.in[I_FWIN] + (size_t)i * D * 2 * FF, D, 2 * FF, (bf16_t*)(wt + WT_FFNIN), src0, 32 * g, true, 64 * kb, scr, lane); continue; }
            r -= IT_FFNIN;
            { const int kb = r / 32, g = r % 32; transpose_item(P.in[I_FWOUT] + (size_t)i * FF * D, FF, D, (bf16_t*)(wt + WT_FFNOUT), 32 * g, 32 * g, false, 64 * kb, scr, lane); }
        }
    }
#ifdef PROBE_PRO2
    }
#endif
    if (P.ws == nullptr) grid.sync();
    GSYNC();
#ifdef PROBE_PRO2
    for (int rep_ = 0; rep_ < 2; ++rep_) { if (rep_) GSYNC();
#endif
    {
        LAS float* vl = (LAS float*)lds; LAS float* red = (LAS float*)(lds + 49152);
        for (int task = bid; task < DEPTH * 68; task += G) { const int i = task / 68; int r = task % 68; const int j = i >> 1;
            const bool mix = r < 24; const int voff = mix ? 0 : 3 * D;
            for (int idx = tid; idx < NS * D; idx += NTHR) { const int s = idx >> 10, k = idx & 1023; vl[k * 12 + s] = MOD[(size_t)(i * NS + s) * 6144 + voff + k]; }
            __syncthreads();
            if (mix) { const float* W = (i & 1) == 0 ? P.in[I_CWIN] + (size_t)j * D * 3072 : P.in[I_AQKV] + (size_t)j * D * 3072;
                gemv9_task(vl, red, W, 3072, r * 128, SWM + (size_t)i * NS * 3072, 3072, nullptr); }
            else { r -= 24; gemv9_task(vl, red, P.in[I_FWIN] + (size_t)i * D * 2 * FF, 2 * FF, r * 128, SWF + (size_t)i * NS * 2 * FF, 2 * FF, nullptr); }
        }
        for (int row0 = gw; row0 < MA; row0 += 4 * ngw) {
            f32x4 v[4][4];
#pragma unroll
            for (int r = 0; r < 4; ++r) { const int row = min(row0 + r * ngw, MA - 1); const bool lat = row < ML;
                const float* src = lat ? P.in[I_X] + (size_t)row * D : P.in[I_CTX] + (size_t)(row - ML) * D;
#pragma unroll
                for (int q = 0; q < 4; ++q) v[r][q] = ((const f32x4*)src)[lane + 64 * q]; }
            asm volatile("" ::: "memory");
#pragma unroll
            for (int r = 0; r < 4; ++r) { const int row = row0 + r * ngw; if (row < MA) { const bool lat = row < ML; const int s = lat ? (row >> 13) : 8;
                float ss = 0.f;
#pragma unroll
                for (int q = 0; q < 4; ++q) ss += (v[r][q][0] * v[r][q][0] + v[r][q][1] * v[r][q][1]) + (v[r][q][2] * v[r][q][2] + v[r][q][3] * v[r][q][3]);
                ss = wave_sum(ss);
                if (lane == 0) RSS[row] = ss;
#pragma unroll
                for (int q = 0; q < 4; ++q) { const int c = 4 * (lane + 64 * q); const f32x4 nv = *(const f32x4*)(P.in[I_NMIX] + c) * (*(const f32x4*)(MOD + (size_t)s * 6144 + D + c) + 1.0f); const f32x4 y = v[r][q] * nv;
                    u32x2 wv; wv.x = pk2(y[0], y[1]); wv.y = pk2(y[2], y[3]); *(u32x2*)(XS + (size_t)row * D + c) = wv; } } }
        }
    }
#ifdef PROBE_PRO2
    }
#endif
    GSYNC();
    int dirw = 0;
    for (int i = 0; i < DEPTH; ++i) {
        const int j = i >> 1; const bool conv = (i & 1) == 0; const bool last = i == DEPTH - 1;
        unsigned char* wt = ws + WS_WT + (size_t)i * WT_LAYER;
        const float* modi = MOD + (size_t)i * NS * 6144;
        float* rssA = RSS + (size_t)(2 * i) * MA; float* rssB = RSS + (size_t)(2 * i + 1) * MA;
        const int Mr = last ? ML : MA;
        const float* xin_l = i == 0 ? P.in[I_X] : P.out; const float* xin_c = i == 0 ? P.in[I_CTX] : XC;
        if (conv) {
            { pg8::Gemm g{XS, (const bf16_t*)(wt + WT_MIXIN), MA, 3072, D}; pg8::StaticOrder S; S.init(MA, 3072, G, bid); S.rev = !dirw; dirw = S.rev;
              EpiConvIn E{rssA, SWM + (size_t)i * NS * 3072, A0, A1};
#ifndef SKIP_G1C
              pg8::gemm_phase<EpiConvIn, pg8::StaticOrder, true, true>(lds, g, S, E);
#ifdef PROBE_GEMM2
              pg8::gemm_phase<EpiConvIn, pg8::StaticOrder, true, true>(lds, g, S, E);
#endif
#endif
 }
            GSYNC();
#ifndef SKIP_CONV
            conv_phase(A0, A1, A3, P.in[I_CW] + (size_t)j * 3 * D, gw, ngw, lane);
#ifdef PROBE_CONV2
            GSYNC();
            conv_phase(A0, A1, A3, P.in[I_CW] + (size_t)j * 3 * D, gw, ngw, lane);
#endif
#endif
            GSYNC();
        } else {
            { pg8::Gemm g{XS, (const bf16_t*)(wt + WT_MIXIN), MA, 3072, D}; pg8::StaticOrder S; S.init(MA, 3072, G, bid); S.rev = !dirw; dirw = S.rev;
              EpiQKV E{rssA, SWM + (size_t)i * NS * 3072, P.in[I_AQN] + j * HD, P.in[I_AKN] + j * HD, A0};
#ifndef SKIP_G1Q
              pg8::gemm_phase<EpiQKV, pg8::StaticOrder, true, true>(lds, g, S, E);
#ifdef PROBE_GEMM2
              pg8::gemm_phase<EpiQKV, pg8::StaticOrder, true, true>(lds, g, S, E);
#endif
#endif
 }
            GSYNC();
#ifndef SKIP_ATTN
            dirw = !dirw;
            attn_phase(lds, A0, A1, A2, A3, P.in[I_ARPB] + (size_t)j * NH * 465, !last, bid, G, dirw);
#ifdef PROBE_ATTN2
            GSYNC();
            attn_phase(lds, A0, A1, A2, A3, P.in[I_ARPB] + (size_t)j * NH * 465, !last, bid, G, dirw);
#endif
#endif
            GSYNC();
        }
        { pg8::Gemm g{A3, (const bf16_t*)(wt + WT_MIXOUT), Mr, D, D}; pg8::StaticOrder S; S.init(Mr, D, G, bid); S.rev = !dirw; dirw = S.rev;
          EpiRes E{xin_l, xin_c, P.out, XC, modi + 2 * D, P.in[I_NFFN] + i * D, modi + 4 * D, XS, rssB};
#ifndef SKIP_G2
#ifdef PROBE_RES2
          { EpiRes E2{xin_l, xin_c, (float*)A0, (float*)A0 + (size_t)ML * D, modi + 2 * D, nullptr, modi + 4 * D, XS, rssB};
            pg8::gemm_phase<EpiRes, pg8::StaticOrder, true, true>(lds, g, S, E2); GSYNC(); }
#endif
          pg8::gemm_phase<EpiRes, pg8::StaticOrder, false, true>(lds, g, S, E);
#endif
 }
        GSYNC();
        { pg8::Gemm g{XS, (const bf16_t*)(wt + WT_FFNIN), Mr, 2 * FF, D}; pg8::StaticOrder S; S.init(Mr, 2 * FF, G, bid); S.rev = !dirw; dirw = S.rev;
          EpiSwi E{rssB, SWF + (size_t)i * NS * 2 * FF, GG};
#ifndef SKIP_F1
          pg8::gemm_phase<EpiSwi, pg8::StaticOrder, true, true>(lds, g, S, E);
#ifdef PROBE_GEMM2
          pg8::gemm_phase<EpiSwi, pg8::StaticOrder, true, true>(lds, g, S, E);
#endif
#endif
 }
        GSYNC();
        { pg8::Gemm g{GG, (const bf16_t*)(wt + WT_FFNOUT), Mr, D, FF}; pg8::StaticOrder S; S.init(Mr, D, G, bid); S.rev = !dirw; dirw = S.rev;
          EpiRes E{P.out, XC, P.out, XC, modi + 5 * D, last ? nullptr : P.in[I_NMIX] + (i + 1) * D, modi + NS * 6144 + D, XS, rssA + 2 * MA};
#ifndef SKIP_F2
#ifdef PROBE_RES2
          { EpiRes E2{P.out, XC, P.out, XC, (const float*)(ws + WS_ZERO), nullptr, modi + 4 * D, XS, rssB};
            pg8::gemm_phase<EpiRes, pg8::StaticOrder, true, true>(lds, g, S, E2); GSYNC(); }
#endif
          pg8::gemm_phase<EpiRes, pg8::StaticOrder, false, true>(lds, g, S, E);
#endif
 }
        if (!last) GSYNC();
    }
}

extern "C" void kernel_launch(void* const* d_in, const int* in_sizes, int n_in, void* d_out, int out_size, void* d_ws, size_t ws_size, hipStream_t stream) {
    static int grid = 0;
    if (grid == 0) {
        if (n_in != 18 || out_size != ML * D || ws_size < WS_END) { fprintf(stderr, "kernel_launch: unexpected shapes (n_in %d, out %d, ws %zu, need %zu)\n", n_in, out_size, ws_size, (size_t)WS_END); grid = -1; return; }
        int dev = 0, cus = 0, per_cu = 0;
        if (hipGetDevice(&dev) != hipSuccess || hipDeviceGetAttribute(&cus, hipDeviceAttributeMultiprocessorCount, dev) != hipSuccess) { grid = -1; return; }
        if (hipFuncSetAttribute((const void*)mega_fwd, hipFuncAttributeMaxDynamicSharedMemorySize, LDS_BYTES) != hipSuccess) { fprintf(stderr, "kernel_launch: hipFuncSetAttribute failed\n"); grid = -1; return; }
        if (hipOccupancyMaxActiveBlocksPerMultiprocessor(&per_cu, (const void*)mega_fwd, NTHR, LDS_BYTES) != hipSuccess || per_cu < 1) { fprintf(stderr, "kernel_launch: occupancy query says %d\n", per_cu); per_cu = 1; }
        (void)hipGetLastError();
        grid = cus;
    }
    if (grid < 0) return;
    if (hipMemsetAsync((char*)d_ws + WS_BAR, 0, BAR_BYTES, stream) != hipSuccess) { fprintf(stderr, "kernel_launch: memset failed\n"); return; }
#ifdef PROBE_RES2
    (void)hipMemsetAsync((char*)d_ws + WS_ZERO, 0, ZERO_BYTES, stream);
#endif
    Params p{};
    for (int i = 0; i < 18; ++i) p.in[i] = (const float*)d_in[i];
    p.out = (float*)d_out; p.ws = (unsigned char*)d_ws;
    void* args[] = {&p};
    hipError_t e = hipLaunchCooperativeKernel((const void*)mega_fwd, dim3(grid), dim3(NTHR), args, LDS_BYTES, stream);
    if (e != hipSuccess) fprintf(stderr, "kernel_launch: cooperative launch failed: %s (grid %d)\n", hipGetErrorString(e), grid);
}
```

```cpp
#include <hip/hip_runtime.h>
#include <hip/hip_cooperative_groups.h>
#include <cstdio>
#include <cstdint>
namespace cg = cooperative_groups;
namespace pg8 {
#define PG8_LAS __attribute__((address_space(3)))
typedef unsigned short bf16_t;
typedef short bf16x8 __attribute__((ext_vector_type(8)));
typedef float f32x4 __attribute__((ext_vector_type(4)));
typedef unsigned u32x4 __attribute__((ext_vector_type(4)));
constexpr int BM = 256, BK = 64, HALF = 128, HTB = HALF * BK * 2  , STAGE_BYTES = 8 * HTB, NXCD = 8, WGM = 2;

__host__ __device__ __forceinline__ int lds_byte(int r, int c) { const int st = (r >> 4) * 2 + (c >> 5), rr = r & 15, cc = c & 31, ob = rr * 64 + cc * 2; return st * 1024 + (ob ^ (((ob >> 9) & 1) << 5)); }
__host__ __device__ __forceinline__ void stage_rc(int b, int& R, int& C) { const int st = b / 1024, sb = b % 1024, swz = sb ^ (((sb >> 9) & 1) << 5); R = (st >> 1) * 16 + swz / 64; C = (st & 1) * 32 + (swz % 64) / 2; }
__host__ __device__ __forceinline__ int perm32(int rho) { const int n = rho >> 4, i = rho & 15; return 8 * (i >> 2) + 4 * n + (i & 3); }

struct Unit { int pm, pn; };
struct Gemm { const bf16_t* A; const bf16_t* Bt; int M, N, K; };

struct StaticOrder {
    int nM, nN, nwg, G, c, rev;
    __host__ __device__ void init(int M, int N, int G_, int c_) { nM = M / BM; nN = N / BM; nwg = nM * nN; G = G_; c = c_; rev = 0; }
    __host__ __device__ bool next(int i, Unit& u) const {
        const long L = (long)i * G + c; if (L >= nwg) return false;
        int wgid = rev ? (int)(nwg - 1 - L) : (int)L; { const int q = nwg / NXCD, r = nwg % NXCD, xcd = wgid % NXCD, off = wgid / NXCD; wgid = (xcd < r ? xcd * (q + 1) : r * (q + 1) + (xcd - r) * q) + off; }
        const int nig = WGM * nN, gid = wgid / nig, fm = gid * WGM, gsz = (nM - fm) < WGM ? (nM - fm) : WGM;
        u.pm = fm + ((wgid % nig) % gsz); u.pn = (wgid % nig) / gsz; return true;
    }
    __device__ __forceinline__ void a_ready(const Unit&) const {}
    __device__ __forceinline__ void done(const Unit&) const {}
};

template <class Epi, class Sched, bool ALIGN_EPI = false, bool SP2 = false>
__device__ __forceinline__ void gemm_phase(PG8_LAS unsigned char* lds, const Gemm g, const Sched& S, const Epi& E) {
    int tid_ = threadIdx.x; asm volatile("" : "+v"(tid_));
    const int tid = tid_, wid = __builtin_amdgcn_readfirstlane(tid >> 6), lane = tid & 63, wr = wid >> 2, wc = wid & 3, fr = lane & 15, fq = lane >> 4;
    const int K = g.K, nt = K / BK;
    unsigned voffA[2], voffB[2];
#pragma unroll
    for (int i = 0; i < 2; ++i) { int R, C; stage_rc(tid * 16 + i * 8192, R, C); const int Rb = Epi::PERM ? ((R & ~31) + perm32(R & 31)) : R;
        voffA[i] = (unsigned)(R * K + C) * 2u; voffB[i] = (unsigned)(Rb * K + C) * 2u; }
    const size_t kstep = (size_t)(BK * 2);
    const size_t hstep = (size_t)HALF * K * 2;
    const size_t tstep = 2 * hstep;
    const unsigned ldsw = (unsigned)wid * 1024u;
    const int aoff = lds_byte(wr * 64 + fr, fq * 8), boff = lds_byte(wc * 32 + fr, fq * 8);
#define PG8_SA(b, h) (((b) * 2 + (h)) * HTB)
#define PG8_SB(b, h) ((4 + (b) * 2 + (h)) * HTB)
#define PG8_STAGE(bufoff, gbase, voff) do { _Pragma("unroll") for (int _i = 0; _i < 2; ++_i) \
        __builtin_amdgcn_global_load_lds((const unsigned*)((const char*)(gbase) + (voff)[_i]), (PG8_LAS unsigned*)(lds + (bufoff) + ldsw + _i * 8192), 16, 0, 0); } while (0)
#define PG8_LDA(dst, b, h) do { _Pragma("unroll") for (int m = 0; m < 4; ++m) _Pragma("unroll") for (int k = 0; k < 2; ++k) dst[m][k] = *(const PG8_LAS bf16x8*)(lds + PG8_SA(b, h) + aoff + m * 2048 + k * 1024); } while (0)
#define PG8_LDB(dst, b, h) do { _Pragma("unroll") for (int n = 0; n < 2; ++n) _Pragma("unroll") for (int k = 0; k < 2; ++k) dst[n][k] = *(const PG8_LAS bf16x8*)(lds + PG8_SB(b, h) + boff + n * 2048 + k * 1024); } while (0)
#define PG8_MMA(ai, bj, At, Bt) do { __builtin_amdgcn_s_setprio(1); _Pragma("unroll") for (int m = 0; m < 4; ++m) _Pragma("unroll") for (int n = 0; n < 2; ++n) _Pragma("unroll") for (int k = 0; k < 2; ++k) \
        acc[ai][bj][m][n] = __builtin_amdgcn_mfma_f32_16x16x32_bf16(Bt[n][k], At[m][k], acc[ai][bj][m][n], 0, 0, 0); __builtin_amdgcn_s_setprio(0); } while (0)
#define PG8_WAIT_V(n) asm volatile("s_waitcnt vmcnt(" #n ")" ::: "memory")
#define PG8_WAIT_L(n) asm volatile("s_waitcnt lgkmcnt(" #n ")" ::: "memory")
#define PG8_BAR __builtin_amdgcn_s_barrier()
#define PG8_SCHED __builtin_amdgcn_sched_barrier(0)
    Unit cur, nxt; int ui = 0;
    if (!S.next(0, cur)) return;
    f32x4 acc[2][2][4][2];
#pragma unroll
    for (int a = 0; a < 2; ++a)
#pragma unroll
        for (int b = 0; b < 2; ++b)
#pragma unroll
            for (int m = 0; m < 4; ++m)
#pragma unroll
                for (int n = 0; n < 2; ++n) acc[a][b][m][n] = (f32x4){0.f, 0.f, 0.f, 0.f};
    bf16x8 At[4][2], B0[2][2], B1[2][2];
    const char* cA = (const char*)g.A + (size_t)cur.pm * tstep; const char* cB = (const char*)g.Bt + (size_t)cur.pn * tstep;
    S.a_ready(cur);
    if constexpr (SP2) {
        PG8_STAGE(PG8_SB(0, 0), cB, voffB); PG8_STAGE(PG8_SB(0, 1), cB + hstep, voffB); PG8_STAGE(PG8_SA(0, 0), cA, voffA); PG8_STAGE(PG8_SA(0, 1), cA + hstep, voffA);
        if (wr == 1) PG8_BAR;
        PG8_WAIT_V(2); PG8_BAR;
        PG8_STAGE(PG8_SB(1, 0), cB + kstep, voffB); PG8_STAGE(PG8_SA(1, 0), cA + kstep, voffA); PG8_STAGE(PG8_SB(1, 1), cB + hstep + kstep, voffB);
        PG8_WAIT_V(6); PG8_BAR;
    } else {
        PG8_STAGE(PG8_SB(0, 0), cB, voffB); PG8_STAGE(PG8_SA(0, 0), cA, voffA); PG8_STAGE(PG8_SB(0, 1), cB + hstep, voffB); PG8_STAGE(PG8_SA(0, 1), cA + hstep, voffA);
        if (wr == 1) PG8_BAR;
        PG8_WAIT_V(4); PG8_BAR;
        PG8_STAGE(PG8_SB(1, 0), cB + kstep, voffB); PG8_STAGE(PG8_SA(1, 0), cA + kstep, voffA); PG8_STAGE(PG8_SB(1, 1), cB + hstep + kstep, voffB);
        PG8_WAIT_V(6); PG8_BAR;
    }
    for (;;) {
        const bool has_next = S.next(ui + 1, nxt);
        const char* nA = has_next ? (const char*)g.A + (size_t)nxt.pm * tstep : cA; const char* nB = has_next ? (const char*)g.Bt + (size_t)nxt.pn * tstep : cB;
        for (int t = 0; t < nt; t += 2) {
            const bool last = (t == nt - 2);
            const char* a1 = cA + (size_t)(t + 1) * kstep;
            const char* a2 = last ? nA : cA + (size_t)(t + 2) * kstep; const char* b2 = last ? nB : cB + (size_t)(t + 2) * kstep;
            const char* a3 = a2 + kstep; const char* b3 = b2 + kstep;
            if (last && has_next) S.a_ready(nxt);
            if constexpr (SP2) {
            PG8_LDB(B0, 0, 0); PG8_LDB(B1, 0, 1); PG8_SCHED; PG8_LDA(At, 0, 0); PG8_STAGE(PG8_SA(1, 1), a1 + hstep, voffA);
            PG8_WAIT_V(8); PG8_WAIT_L(0); PG8_BAR; PG8_MMA(0, 0, At, B0); PG8_MMA(0, 1, At, B1); PG8_BAR; PG8_SCHED;
            PG8_LDA(At, 0, 1); PG8_STAGE(PG8_SB(0, 0), b2, voffB); PG8_STAGE(PG8_SB(0, 1), b2 + hstep, voffB); PG8_STAGE(PG8_SA(0, 0), a2, voffA);
            PG8_WAIT_V(8); PG8_WAIT_L(0); PG8_BAR; PG8_MMA(1, 0, At, B0); PG8_MMA(1, 1, At, B1); PG8_BAR; PG8_SCHED;
            PG8_LDB(B0, 1, 0); PG8_LDB(B1, 1, 1); PG8_SCHED; PG8_LDA(At, 1, 0); PG8_STAGE(PG8_SA(0, 1), a2 + hstep, voffA);
            PG8_WAIT_V(8); PG8_WAIT_L(0); PG8_BAR; PG8_MMA(0, 0, At, B0); PG8_MMA(0, 1, At, B1); PG8_BAR; PG8_SCHED;
            PG8_LDA(At, 1, 1); PG8_STAGE(PG8_SB(1, 0), b3, voffB); PG8_STAGE(PG8_SB(1, 1), b3 + hstep, voffB); PG8_STAGE(PG8_SA(1, 0), a3, voffA);
            PG8_WAIT_V(8); PG8_WAIT_L(0); PG8_BAR; PG8_MMA(1, 0, At, B0); PG8_MMA(1, 1, At, B1); PG8_BAR; PG8_SCHED;
            } else {
            PG8_LDB(B0, 0, 0); PG8_SCHED; PG8_LDA(At, 0, 0); PG8_STAGE(PG8_SA(1, 1), a1 + hstep, voffA);
            PG8_WAIT_L(8); PG8_BAR; PG8_WAIT_L(0); PG8_MMA(0, 0, At, B0); PG8_BAR; PG8_SCHED;
            PG8_LDB(B1, 0, 1); PG8_STAGE(PG8_SB(0, 0), b2, voffB);
            PG8_BAR; PG8_WAIT_L(0); PG8_MMA(0, 1, At, B1); PG8_BAR;
            PG8_LDA(At, 0, 1); PG8_STAGE(PG8_SA(0, 0), a2, voffA);
            PG8_BAR; PG8_WAIT_L(0); PG8_MMA(1, 0, At, B0); PG8_BAR; PG8_SCHED;
            PG8_STAGE(PG8_SB(0, 1), b2 + hstep, voffB);
            PG8_WAIT_V(6); PG8_BAR; PG8_MMA(1, 1, At, B1); PG8_BAR;
            PG8_LDB(B0, 1, 0); PG8_SCHED; PG8_LDA(At, 1, 0); PG8_STAGE(PG8_SA(0, 1), a2 + hstep, voffA);
            PG8_WAIT_L(8); PG8_BAR; PG8_WAIT_L(0); PG8_MMA(0, 0, At, B0); PG8_BAR; PG8_SCHED;
            PG8_LDB(B1, 1, 1); PG8_STAGE(PG8_SB(1, 0), b3, voffB);
            PG8_BAR; PG8_WAIT_L(0); PG8_MMA(0, 1, At, B1); PG8_BAR;
            PG8_LDA(At, 1, 1); PG8_STAGE(PG8_SA(1, 0), a3, voffA);
            PG8_BAR; PG8_WAIT_L(0); PG8_MMA(1, 0, At, B0); PG8_BAR; PG8_SCHED;
            PG8_STAGE(PG8_SB(1, 1), b3 + hstep, voffB);
            PG8_WAIT_V(6); PG8_BAR; PG8_MMA(1, 1, At, B1); PG8_BAR;
            }
        }
        if constexpr (ALIGN_EPI) { if (wr == 0) PG8_BAR; }
        if constexpr (!Epi::AFTER_DRAIN) { E(acc, cur, wr, wc, fr, fq); S.done(cur); }
        if (!has_next) break;
#pragma unroll
        for (int a = 0; a < 2; ++a)
#pragma unroll
            for (int b = 0; b < 2; ++b)
#pragma unroll
                for (int m = 0; m < 4; ++m)
#pragma unroll
                    for (int n = 0; n < 2; ++n) acc[a][b][m][n] = (f32x4){0.f, 0.f, 0.f, 0.f};
        cur = nxt; cA = nA; cB = nB; ++ui;
        if constexpr (ALIGN_EPI) { if (wr == 1) PG8_BAR; }
    }
    PG8_WAIT_V(0);
    if constexpr (!ALIGN_EPI) { if (wr == 0) PG8_BAR; }
    PG8_BAR;
    if constexpr (Epi::AFTER_DRAIN) { E.fused(acc, cur, wr, wc, fr, fq, lds, wid, lane); S.done(cur); }
#undef PG8_SA
#undef PG8_SB
#undef PG8_STAGE
#undef PG8_LDA
#undef PG8_LDB
#undef PG8_MMA
#undef PG8_WAIT_V
#undef PG8_WAIT_L
#undef PG8_BAR
#undef PG8_SCHED
}
}

#define LAS __attribute__((address_space(3)))
using pg8::bf16_t; using pg8::bf16x8; using pg8::f32x4; using pg8::u32x4; using pg8::Unit;
typedef unsigned u32x2 __attribute__((ext_vector_type(2)));
typedef float f32x2 __attribute__((ext_vector_type(2)));
typedef float f32x16 __attribute__((ext_vector_type(16)));
typedef __bf16 bf16v2 __attribute__((ext_vector_type(2)));

constexpr int D = 1024, NB = 8, SEQ = 8192, DEPTH = 4, CTX = 256, NH = 16, HD = 64, FF = 2816, GW = 64;
constexpr int ML = NB * SEQ, MC = NB * CTX, MA = ML + MC;
constexpr int NS = 9;
constexpr float EPS = 1e-6f;
constexpr int NTHR = 512, NWAVE = 8;
constexpr int LDS_BYTES = 147456;

constexpr size_t MiB = 1u << 20;
constexpr size_t WS_MOD = 0;
constexpr size_t WS_SWM = 1 * MiB;
constexpr size_t WS_SWF = 2 * MiB;
constexpr size_t WS_RSS = 3 * MiB;
constexpr size_t WS_XC = 6 * MiB;
constexpr size_t WS_BAR = 15 * MiB, BAR_BYTES = 16384;
#ifdef PROBE_RES2
constexpr size_t WS_ZERO = 15 * MiB + 65536, ZERO_BYTES = 262144;
#endif
constexpr size_t WS_WT = 16 * MiB;
constexpr size_t WT_MIXIN = 0, WT_MIXOUT = (size_t)3072 * 1024 * 2, WT_FFNIN = WT_MIXOUT + (size_t)1024 * 1024 * 2, WT_FFNOUT = WT_FFNIN + (size_t)5632 * 1024 * 2, WT_LAYER = WT_FFNOUT + (size_t)1024 * 2816 * 2;
constexpr size_t WS_XS = 128 * MiB;
constexpr size_t ACT = (size_t)MA * D * 2;
constexpr size_t WS_A0 = 264 * MiB;
constexpr size_t WS_A1 = WS_A0 + ACT;
constexpr size_t WS_A2 = WS_A1 + ACT;
constexpr size_t WS_A3 = WS_A2 + ACT;
constexpr size_t WS_G = WS_A0;
constexpr size_t WS_END = WS_A3 + ACT;
static_assert(WS_WT + 4 * WT_LAYER <= WS_XS && WS_XS + ACT <= WS_A0 && (size_t)MA * FF * 2 <= 3 * ACT, "d_ws map");

__device__ __forceinline__ unsigned pk2(float a, float b) { f32x2 v = {a, b}; return __builtin_bit_cast(unsigned, __builtin_convertvector(v, bf16v2)); }
__device__ __forceinline__ float bflo(unsigned u) { return __uint_as_float(u << 16); }
__device__ __forceinline__ float bfhi(unsigned u) { return __uint_as_float(u & 0xffff0000u); }
__device__ __forceinline__ float wave_sum(float v) {
#pragma unroll
    for (int o = 1; o < 64; o <<= 1) v += __shfl_xor(v, o);
    return v;
}
#define LDS_WAIT() asm volatile("s_waitcnt lgkmcnt(0)" ::: "memory")


struct EpiRes {
    static constexpr bool PERM = false, AFTER_DRAIN = false;
    const float* xin_l; const float* xin_c; float* xout_l; float* xout_c;
    const float* gate;
    const float* nrm;
    const float* nsc;
    bf16_t* xs; float* rss;
    __device__ __forceinline__ void operator()(const f32x4 (&acc)[2][2][4][2], const Unit& u, int wr, int wc, int fr, int fq) const {
        const bool lat = u.pm < 256; const int s = lat ? (u.pm >> 5) : 8;
        const size_t toff = (size_t)(lat ? u.pm : u.pm - 256) * 256 * D;
        const float* xi = (lat ? xin_l : xin_c) + toff; float* xo = (lat ? xout_l : xout_c) + toff;
        bf16_t* xsb = xs + (size_t)u.pm * 256 * D; float* rsb = rss + u.pm * 256;
        const float* gt = gate + s * 6144 + u.pn * 256; const float* nsp = nsc + s * 6144 + u.pn * 256; const float* nrp = nrm + u.pn * 256;
        const unsigned cl = wc * 32 + 4 * fq;
        const unsigned voff = (unsigned)(wr * 64 + fr) * D + u.pn * 256 + cl;
        float ss[2][4];
#pragma unroll
        for (int ai = 0; ai < 2; ++ai)
#pragma unroll
            for (int m = 0; m < 4; ++m) ss[ai][m] = 0.f;
#pragma unroll
        for (int bj = 0; bj < 2; ++bj)
#pragma unroll
            for (int n = 0; n < 2; ++n) { const int co = bj * 128 + n * 16;
                f32x4 xv[2][4];
                const f32x4 gv = *(const f32x4*)(gt + co + cl);
                f32x4 nv = (f32x4){0.f, 0.f, 0.f, 0.f}; if (nrm) nv = *(const f32x4*)(nrp + co + cl) * (*(const f32x4*)(nsp + co + cl) + 1.0f);
#pragma unroll
                for (int ai = 0; ai < 2; ++ai)
#pragma unroll
                    for (int m = 0; m < 4; ++m) xv[ai][m] = *(const f32x4*)(xi + (size_t)(ai * 128 + m * 16) * D + co + voff);
                asm volatile("" ::: "memory");
#pragma unroll
                for (int ai = 0; ai < 2; ++ai)
#pragma unroll
                    for (int m = 0; m < 4; ++m) { const size_t rb = (size_t)(ai * 128 + m * 16) * D + co;
                        const f32x4 x2 = xv[ai][m] + gv * acc[ai][bj][m][n]; *(f32x4*)(xo + rb + voff) = x2;
                        if (nrm) { ss[ai][m] += (x2[0] * x2[0] + x2[1] * x2[1]) + (x2[2] * x2[2] + x2[3] * x2[3]); const f32x4 y = x2 * nv; u32x2 w; w.x = pk2(y[0], y[1]); w.y = pk2(y[2], y[3]);
                            *(u32x2*)(xsb + rb + voff) = w; } }
                asm volatile("" ::: "memory");
            }
        if (nrm) {
#pragma unroll
            for (int ai = 0; ai < 2; ++ai)
#pragma unroll
                for (int m = 0; m < 4; ++m) { float t = ss[ai][m]; t += __shfl_xor(t, 16); t += __shfl_xor(t, 32); if (fq == 0) unsafeAtomicAdd(rsb + (ai * 128 + m * 16) + (wr * 64 + fr), t); } }
    }
};
struct EpiConvIn {
    static constexpr bool PERM = false, AFTER_DRAIN = false;
    const float* rss; const float* sW;
    bf16_t* BB; bf16_t* ZZ;
    __device__ __forceinline__ void operator()(const f32x4 (&acc)[2][2][4][2], const Unit& u, int wr, int wc, int fr, int fq) const {
        const int s = u.pm < 256 ? (u.pm >> 5) : 8; const float* sw = sW + s * 3072; const float* rsb = rss + u.pm * 256;
        const unsigned rl = wr * 64 + fr, cl = wc * 32 + 8 * fq;
        if (u.pn < 4) {
            asm volatile("" ::: "memory");
            const float* swb = sw + u.pn * 256; bf16_t* ob = BB + (size_t)u.pm * 256 * D + u.pn * 256; const unsigned voff = rl * D + cl;
            f32x4 sv[2][2];
#pragma unroll
            for (int bj = 0; bj < 2; ++bj)
#pragma unroll
                for (int n = 0; n < 2; ++n) sv[bj][n] = *(const f32x4*)(swb + bj * 128 + 4 * n + cl);
#pragma unroll
            for (int ai = 0; ai < 2; ++ai) { float rs4[4];
#pragma unroll
                for (int m = 0; m < 4; ++m) rs4[m] = rsqrtf(*(rsb + (ai * 128 + m * 16) + rl) * (1.0f / D) + EPS);
                asm volatile("" ::: "memory");
#pragma unroll
                for (int m = 0; m < 4; ++m) { const float rstd = rs4[m];
#pragma unroll
                    for (int bj = 0; bj < 2; ++bj) { const f32x4 v0 = acc[ai][bj][m][0] * rstd + sv[bj][0], v1 = acc[ai][bj][m][1] * rstd + sv[bj][1];
                        u32x4 w; w.x = pk2(v0[0], v0[1]); w.y = pk2(v0[2], v0[3]); w.z = pk2(v1[0], v1[1]); w.w = pk2(v1[2], v1[3]);
                        *(u32x4*)(ob + (size_t)(ai * 128 + m * 16) * D + bj * 128 + voff) = w; }
                    asm volatile("" ::: "memory"); } }
        } else {
            asm volatile("" ::: "memory");
            const float* swb = sw + (u.pn - 4) * 128; bf16_t* ob = ZZ + (size_t)u.pm * 256 * D + (u.pn - 4) * 128; const unsigned voff = rl * D + cl;
            f32x4 sc[2], su[2];
#pragma unroll
            for (int n = 0; n < 2; ++n) { sc[n] = *(const f32x4*)(swb + 1024 + 4 * n + cl); su[n] = *(const f32x4*)(swb + 2048 + 4 * n + cl); }
#pragma unroll
            for (int ai = 0; ai < 2; ++ai) { float rs4[4];
#pragma unroll
                for (int m = 0; m < 4; ++m) rs4[m] = rsqrtf(*(rsb + (ai * 128 + m * 16) + rl) * (1.0f / D) + EPS);
                asm volatile("" ::: "memory");
#pragma unroll
                for (int m = 0; m < 4; ++m) { const float rstd = rs4[m];
                    const f32x4 z0 = (acc[ai][0][m][0] * rstd + sc[0]) * (acc[ai][1][m][0] * rstd + su[0]), z1 = (acc[ai][0][m][1] * rstd + sc[1]) * (acc[ai][1][m][1] * rstd + su[1]);
                    u32x4 w; w.x = pk2(z0[0], z0[1]); w.y = pk2(z0[2], z0[3]); w.z = pk2(z1[0], z1[1]); w.w = pk2(z1[2], z1[3]);
                    *(u32x4*)(ob + (size_t)(ai * 128 + m * 16) * D + voff) = w;
                    asm volatile("" ::: "memory"); } }
        }
    }
};
struct EpiQKV {
    static constexpr bool PERM = false, AFTER_DRAIN = false;
    const float* rss; const float* sW; const float* gq; const float* gk; bf16_t* QKV;
    __device__ __forceinline__ void operator()(const f32x4 (&acc)[2][2][4][2], const Unit& u, int wr, int wc, int fr, int fq) const {
        const int s = u.pm < 256 ? (u.pm >> 5) : 8; const float* rsb = rss + u.pm * 256;
        const int part = u.pn >> 2, head = 4 * (u.pn & 3) + wc;
        const float* sw = sW + s * 3072 + 1024 * part + 64 * head;
        const float* gp = (part == 0 ? gq : gk); const float gs = part == 0 ? 0.125f * 1.4426950408889634f : 1.0f;
        bf16_t* ob = QKV + (size_t)part * (ACT / 2) + (size_t)u.pm * 256 * D + 64 * head;
        const unsigned rl = wr * 64 + fr, voff = rl * D + 8 * fq;
        float rstdv[2][4];
#pragma unroll
        for (int ai = 0; ai < 2; ++ai)
#pragma unroll
            for (int m = 0; m < 4; ++m) rstdv[ai][m] = rsqrtf(*(rsb + (ai * 128 + m * 16) + rl) * (1.0f / D) + EPS);
        asm volatile("" ::: "memory");
        f32x4 sv[2][2], gv[2][2];
#pragma unroll
        for (int bj = 0; bj < 2; ++bj)
#pragma unroll
            for (int n = 0; n < 2; ++n) { sv[bj][n] = *(const f32x4*)(sw + 32 * bj + 4 * n + 8 * fq); gv[bj][n] = *(const f32x4*)(gp + 32 * bj + 4 * n + 8 * fq) * gs; }
#pragma unroll
        for (int ai = 0; ai < 2; ++ai)
#pragma unroll
            for (int m = 0; m < 4; ++m) { const float rstd = rstdv[ai][m];
                f32x4 v00 = acc[ai][0][m][0] * rstd + sv[0][0], v01 = acc[ai][0][m][1] * rstd + sv[0][1], v10 = acc[ai][1][m][0] * rstd + sv[1][0], v11 = acc[ai][1][m][1] * rstd + sv[1][1];
                if (part < 2) { float ss = ((v00[0] * v00[0] + v00[1] * v00[1]) + (v00[2] * v00[2] + v00[3] * v00[3])) + ((v01[0] * v01[0] + v01[1] * v01[1]) + (v01[2] * v01[2] + v01[3] * v01[3]))
                                         + ((v10[0] * v10[0] + v10[1] * v10[1]) + (v10[2] * v10[2] + v10[3] * v10[3])) + ((v11[0] * v11[0] + v11[1] * v11[1]) + (v11[2] * v11[2] + v11[3] * v11[3]));
                    ss += __shfl_xor(ss, 16); ss += __shfl_xor(ss, 32); const float r = rsqrtf(ss * (1.0f / HD) + EPS);
                    v00 = v00 * r * gv[0][0]; v01 = v01 * r * gv[0][1]; v10 = v10 * r * gv[1][0]; v11 = v11 * r * gv[1][1]; }
                bf16_t* orow = ob + (size_t)(ai * 128 + m * 16) * D;
                { u32x4 w; w.x = pk2(v00[0], v00[1]); w.y = pk2(v00[2], v00[3]); w.z = pk2(v01[0], v01[1]); w.w = pk2(v01[2], v01[3]); *(u32x4*)(orow + voff) = w; }
                { u32x4 w; w.x = pk2(v10[0], v10[1]); w.y = pk2(v10[2], v10[3]); w.z = pk2(v11[0], v11[1]); w.w = pk2(v11[2], v11[3]); *(u32x4*)(orow + 32 + voff) = w; } }
    }
};
struct EpiSwi {
    static constexpr bool PERM = false, AFTER_DRAIN = false;
    const float* rss; const float* sW;
    bf16_t* G;
    __device__ __forceinline__ void operator()(const f32x4 (&acc)[2][2][4][2], const Unit& u, int wr, int wc, int fr, int fq) const {
        const int s = u.pm < 256 ? (u.pm >> 5) : 8; const float* swb = sW + s * (2 * FF) + u.pn * 128; const float* rsb = rss + u.pm * 256;
        bf16_t* ob = G + (size_t)u.pm * 256 * FF + u.pn * 128;
        const unsigned rl = wr * 64 + fr, cl = wc * 32 + 8 * fq, voff = rl * FF + cl;
        float rstdv[2][4];
#pragma unroll
        for (int ai = 0; ai < 2; ++ai)
#pragma unroll
            for (int m = 0; m < 4; ++m) rstdv[ai][m] = rsqrtf(*(rsb + (ai * 128 + m * 16) + rl) * (1.0f / D) + EPS);
        asm volatile("" ::: "memory");
        f32x4 sg[2], su[2];
#pragma unroll
        for (int n = 0; n < 2; ++n) { sg[n] = *(const f32x4*)(swb + 4 * n + cl); su[n] = *(const f32x4*)(swb + FF + 4 * n + cl); }
#pragma unroll
        for (int ai = 0; ai < 2; ++ai)
#pragma unroll
            for (int m = 0; m < 4; ++m) { const float rstd = rstdv[ai][m];
                f32x4 o[2];
#pragma unroll
                for (int n = 0; n < 2; ++n) { const f32x4 g = acc[ai][0][m][n] * rstd + sg[n], up = acc[ai][1][m][n] * rstd + su[n];
#pragma unroll
                    for (int e = 0; e < 4; ++e) o[n][e] = g[e] * __builtin_amdgcn_rcpf(1.0f + __builtin_amdgcn_exp2f(g[e] * -1.4426950408889634f)) * up[e]; }
                u32x4 w; w.x = pk2(o[0][0], o[0][1]); w.y = pk2(o[0][2], o[0][3]); w.z = pk2(o[1][0], o[1][1]); w.w = pk2(o[1][2], o[1][3]);
                *(u32x4*)(ob + (size_t)(ai * 128 + m * 16) * FF + voff) = w; }
    }
};

__device__ __forceinline__ void gemv9_task(LAS float* vl, LAS float* red, const float* W, int ldw, int col0, float* out, int ostride, const float* bias) {
    const int tid = threadIdx.x, lane = tid & 63, w = tid >> 6;
    float a[NS][2];
#pragma unroll
    for (int s = 0; s < NS; ++s) { a[s][0] = 0.f; a[s][1] = 0.f; }
    const float* wp = W + (size_t)(128 * w) * ldw + col0 + 2 * lane;
#pragma unroll 8
    for (int kk = 0; kk < 128; ++kk) {
        const f32x2 wv = *(const f32x2*)(wp + (size_t)kk * ldw);
        const LAS f32x4* v = (const LAS f32x4*)(vl + (128 * w + kk) * 12);
        const f32x4 v0 = v[0], v1 = v[1], v2 = v[2];
        a[0][0] += v0[0] * wv[0]; a[0][1] += v0[0] * wv[1]; a[1][0] += v0[1] * wv[0]; a[1][1] += v0[1] * wv[1];
        a[2][0] += v0[2] * wv[0]; a[2][1] += v0[2] * wv[1]; a[3][0] += v0[3] * wv[0]; a[3][1] += v0[3] * wv[1];
        a[4][0] += v1[0] * wv[0]; a[4][1] += v1[0] * wv[1]; a[5][0] += v1[1] * wv[0]; a[5][1] += v1[1] * wv[1];
        a[6][0] += v1[2] * wv[0]; a[6][1] += v1[2] * wv[1]; a[7][0] += v1[3] * wv[0]; a[7][1] += v1[3] * wv[1];
        a[8][0] += v2[0] * wv[0]; a[8][1] += v2[0] * wv[1];
    }
#pragma unroll
    for (int s = 0; s < NS; ++s) { red[(w * NS + s) * 128 + 2 * lane] = a[s][0]; red[(w * NS + s) * 128 + 2 * lane + 1] = a[s][1]; }
    __syncthreads();
    for (int idx = tid; idx < NS * 128; idx += NTHR) { const int s = idx >> 7, c = idx & 127; float t = bias ? bias[col0 + c] : 0.f;
#pragma unroll
        for (int ww = 0; ww < NWAVE; ++ww) t += red[(ww * NS + s) * 128 + c];
        out[(size_t)s * ostride + col0 + c] = t; }
    __syncthreads();
}

__device__ __forceinline__ void transpose_item(const float* W, int K, int N, bf16_t* WT, int src0, int nrow0, bool perm, int k0, LAS float* scr, int lane) {
#pragma unroll
    for (int i = 0; i < 32; ++i) { const int kk = 2 * i + (lane >> 5); scr[kk * 33 + (lane & 31)] = W[(size_t)(k0 + kk) * N + src0 + (lane & 31)]; }
    LDS_WAIT(); asm volatile("" ::: "memory");
    const int c = lane & 7;
#pragma unroll
    for (int j = 0; j < 4; ++j) { const int nl = (lane >> 3) + 8 * j; const int pc = perm ? pg8::perm32(nl) : nl; const LAS float* s = scr + (8 * c) * 33 + pc;
        u32x4 o; o.x = pk2(s[0 * 33], s[1 * 33]); o.y = pk2(s[2 * 33], s[3 * 33]); o.z = pk2(s[4 * 33], s[5 * 33]); o.w = pk2(s[6 * 33], s[7 * 33]);
        *(u32x4*)(WT + (size_t)(nrow0 + nl) * K + k0 + 8 * c) = o; }
    LDS_WAIT(); asm volatile("" ::: "memory");
}

struct Params { const float* in[18]; float* out; unsigned char* ws; };
enum { I_X = 0, I_C, I_CTX, I_CCTX, I_WADA, I_BADA, I_NMIX, I_NFFN, I_CWIN, I_CW, I_CWOUT, I_AQKV, I_AQN, I_AKN, I_ARPB, I_AWOUT, I_FWIN, I_FWOUT };

__device__ __forceinline__ void conv_phase(const bf16_t* BB, const bf16_t* ZZ, bf16_t* A3, const float* cw, int gw_, int ngw, int lane_) {
    int lane = lane_, gw = gw_; asm volatile("" : "+v"(lane), "+s"(gw));
    constexpr int CH = 33; constexpr int NT = MA / CH; static_assert(NT * CH == MA, "conv chunks");
    f32x4 w0[4], w1[4], w2[4];
#pragma unroll
    for (int q = 0; q < 4; ++q) { w0[q] = *(const f32x4*)(cw + 16 * lane + 4 * q); w1[q] = *(const f32x4*)(cw + D + 16 * lane + 4 * q); w2[q] = *(const f32x4*)(cw + 2 * D + 16 * lane + 4 * q); }
    for (int task = gw; task < NT; task += ngw) {
        const int g0 = task * CH;
        const u32x4 zero = {0u, 0u, 0u, 0u};
        u32x4 zp[2], zc[2], nz[3][2], nb[3][2];
        { const u32x4* p = (const u32x4*)(ZZ + (size_t)g0 * D + 16 * lane); zc[0] = p[0]; zc[1] = p[1]; }
        if (g0 > 0) { const u32x4* p = (const u32x4*)(ZZ + (size_t)(g0 - 1) * D + 16 * lane); zp[0] = p[0]; zp[1] = p[1]; } else { zp[0] = zero; zp[1] = zero; }
#pragma unroll
        for (int k = 0; k < 3; ++k) { const int g = g0 + k;
            if (g + 1 < MA) { const u32x4* p = (const u32x4*)(ZZ + (size_t)(g + 1) * D + 16 * lane); nz[k][0] = p[0]; nz[k][1] = p[1]; } else { nz[k][0] = zero; nz[k][1] = zero; }
            { const u32x4* p = (const u32x4*)(BB + (size_t)g * D + 16 * lane); nb[k][0] = p[0]; nb[k][1] = p[1]; } }
        for (int grp = 0; grp < CH / 3; ++grp) {
            u32x4 pz[3][2], pb[3][2];
#pragma unroll
            for (int k = 0; k < 3; ++k) { const int g = g0 + 3 * (grp + 1) + k;
                if (grp + 1 < CH / 3) {
                    if (g + 1 < MA) { const u32x4* p = (const u32x4*)(ZZ + (size_t)(g + 1) * D + 16 * lane); pz[k][0] = p[0]; pz[k][1] = p[1]; } else { pz[k][0] = zero; pz[k][1] = zero; }
                    { const u32x4* p = (const u32x4*)(BB + (size_t)g * D + 16 * lane); pb[k][0] = p[0]; pb[k][1] = p[1]; } }
                else { pz[k][0] = zero; pz[k][1] = zero; pb[k][0] = zero; pb[k][1] = zero; } }
#pragma unroll
            for (int k = 0; k < 3; ++k) {
                const int g = g0 + 3 * grp + k;
                const int pos = g < ML ? (g & (SEQ - 1)) : ((g - ML) & (CTX - 1)); const int L = g < ML ? SEQ : CTX;
                const float mp = pos > 0 ? 1.f : 0.f, mn = pos < L - 1 ? 1.f : 0.f;
                u32x4 ov[2];
#pragma unroll
                for (int hh = 0; hh < 2; ++hh)
#pragma unroll
                    for (int q = 0; q < 4; ++q) { const int wq = hh * 2 + (q >> 1), e0 = (q & 1) * 2;
                        const float lo = bflo(nb[k][hh][q]) * (w0[wq][e0] * mp * bflo(zp[hh][q]) + w1[wq][e0] * bflo(zc[hh][q]) + w2[wq][e0] * mn * bflo(nz[k][hh][q]));
                        const float hi = bfhi(nb[k][hh][q]) * (w0[wq][e0 + 1] * mp * bfhi(zp[hh][q]) + w1[wq][e0 + 1] * bfhi(zc[hh][q]) + w2[wq][e0 + 1] * mn * bfhi(nz[k][hh][q]));
                        ov[hh][q] = pk2(lo, hi); }
                { u32x4* p = (u32x4*)(A3 + (size_t)g * D + 16 * lane); p[0] = ov[0]; p[1] = ov[1]; }
                zp[0] = zc[0]; zp[1] = zc[1]; zc[0] = nz[k][0]; zc[1] = nz[k][1];
            }
#pragma unroll
            for (int k = 0; k < 3; ++k) { nz[k][0] = pz[k][0]; nz[k][1] = pz[k][1]; nb[k][0] = pb[k][0]; nb[k][1] = pb[k][1]; }
        }
    }
}

constexpr int KT_SZ = 64 * 144, VT_PITCH = 192, VT_SZ = 64 * VT_PITCH, AT_KT = 0, AT_VT = 2 * KT_SZ, AT_RPB = AT_VT + 2 * VT_SZ;
constexpr float LOG2E = 1.4426950408889634f;
__device__ __forceinline__ int rstart(int r) { return min(max(r - 4, 0), SEQ / GW - 8); }
#define MFMA32(a, b, c) __builtin_amdgcn_mfma_f32_32x32x16_bf16((a), (b), (c), 0, 0, 0)
typedef short s16x4 __attribute__((ext_vector_type(4)));
__device__ __forceinline__ bf16x8 vt_frag(const LAS unsigned char* vlane, int off) {
    const s16x4 lo = __builtin_amdgcn_ds_read_tr16_b64_v4i16((LAS s16x4*)(vlane + off)), hi2 = __builtin_amdgcn_ds_read_tr16_b64_v4i16((LAS s16x4*)(vlane + off + 8 * VT_PITCH));
    return __builtin_shufflevector(lo, hi2, 0, 1, 2, 3, 4, 5, 6, 7);
}
__device__ __forceinline__ const LAS unsigned char* vt_lane(const LAS unsigned char* vt, int l31, int hi) { return vt + (4 * hi + ((l31 >> 2) & 3)) * VT_PITCH + (16 * ((l31 >> 4) & 1) + 4 * (l31 & 3)) * 2; }
template <int MODE>
__device__ __forceinline__ void attn_tile(const LAS unsigned char* kt, const LAS unsigned char* vt, const LAS float* rpl, int wcs, const bf16x8 (&qf)[4], int l31, int hi, f32x16& o0, f32x16& o1, f32x16& lacc) {
    bf16x8 kf[2][4];
#pragma unroll
    for (int kb2 = 0; kb2 < 2; ++kb2)
#pragma unroll
        for (int s = 0; s < 4; ++s) kf[kb2][s] = *(const LAS bf16x8*)(kt + (32 * kb2 + l31) * 144 + (16 * s + 8 * hi) * 2);
    float bias[2][16];
#pragma unroll
    for (int kb2 = 0; kb2 < 2; ++kb2)
#pragma unroll
        for (int i = 0; i < 16; ++i) { const bool live = MODE != 0 && (MODE == 1 ? (kb2 == 0 || i < 4) : (kb2 == 1 || i >= 12)); bias[kb2][i] = live ? rpl[32 * kb2 + (i & 3) + 8 * (i >> 2)] : 0.f; }
    __builtin_amdgcn_sched_barrier(0);
    f32x16 st[2];
#pragma unroll
    for (int kb2 = 0; kb2 < 2; ++kb2) {
#pragma unroll
        for (int i = 0; i < 16; ++i) st[kb2][i] = 0.f;
    }
    __builtin_amdgcn_s_setprio(1);
#pragma unroll
    for (int s = 0; s < 4; ++s) { st[0] = MFMA32(kf[0][s], qf[s], st[0]); st[1] = MFMA32(kf[1][s], qf[s], st[1]); }
    __builtin_amdgcn_s_setprio(0);
    const LAS unsigned char* vl = vt_lane(vt, l31, hi);
    bf16x8 vf0[2][2], vf1[2][2];
#pragma unroll
    for (int kb2 = 0; kb2 < 2; ++kb2)
#pragma unroll
        for (int t = 0; t < 2; ++t) { const bool livestep = MODE == 0 || (MODE == 1 ? !(kb2 == 1 && t == 1) : !(kb2 == 0 && t == 0));
            if (livestep) { const int ko = (32 * kb2 + 16 * t) * VT_PITCH; vf0[kb2][t] = vt_frag(vl, ko); vf1[kb2][t] = vt_frag(vl, ko + 64); }
            else { vf0[kb2][t] = kf[0][0]; vf1[kb2][t] = kf[0][0]; } }
    __builtin_amdgcn_sched_barrier(0);
#pragma unroll
    for (int kb2 = 0; kb2 < 2; ++kb2)
#pragma unroll
        for (int i = 0; i < 16; ++i) {
            const int kcc = 32 * kb2 + (i & 3) + 8 * (i >> 2);
            const bool live = MODE == 0 || (MODE == 1 ? (kb2 == 0 || i < 4) : (kb2 == 1 || i >= 12));
            if (!live) { st[kb2][i] = 0.f; continue; }
            if (MODE == 0) st[kb2][i] = __builtin_amdgcn_exp2f(st[kb2][i]);
            else { const bool valid = (unsigned)(kcc - wcs) < 16u; const float pe = __builtin_amdgcn_exp2f(st[kb2][i] + bias[kb2][i]); st[kb2][i] = valid ? pe : 0.f; }
        }
    u32x4 onesw; onesw.x = 0x3f803f80u; onesw.y = 0x3f803f80u; onesw.z = 0x3f803f80u; onesw.w = 0x3f803f80u;
    const bf16x8 ones = __builtin_bit_cast(bf16x8, onesw);
#pragma unroll
    for (int kb2 = 0; kb2 < 2; ++kb2)
#pragma unroll
        for (int t = 0; t < 2; ++t) {
            const bool livestep = MODE == 0 || (MODE == 1 ? !(kb2 == 1 && t == 1) : !(kb2 == 0 && t == 0));
            if (!livestep) continue;
            u32x4 pw; pw.x = pk2(st[kb2][8 * t + 0], st[kb2][8 * t + 1]); pw.y = pk2(st[kb2][8 * t + 2], st[kb2][8 * t + 3]); pw.z = pk2(st[kb2][8 * t + 4], st[kb2][8 * t + 5]); pw.w = pk2(st[kb2][8 * t + 6], st[kb2][8 * t + 7]);
            const bf16x8 pf = __builtin_bit_cast(bf16x8, pw);
            __builtin_amdgcn_s_setprio(1);
            o0 = MFMA32(vf0[kb2][t], pf, o0);
            o1 = MFMA32(vf1[kb2][t], pf, o1);
            lacc = MFMA32(ones, pf, lacc);
            __builtin_amdgcn_s_setprio(0);
        }
}
__device__ __forceinline__ void attn_wtile(const LAS unsigned char* kt, const LAS unsigned char* vt, const LAS float* rpl, int wcsr, int kb0, const bf16x8 (&qf)[4], int l31, int hi, f32x16& o0, f32x16& o1, f32x16& lacc) {
    bf16x8 kf[4];
#pragma unroll
    for (int s = 0; s < 4; ++s) kf[s] = *(const LAS bf16x8*)(kt + (kb0 + l31) * 144 + (16 * s + 8 * hi) * 2);
    float bias[16];
#pragma unroll
    for (int i = 0; i < 16; ++i) bias[i] = rpl[(i & 3) + 8 * (i >> 2)];
    __builtin_amdgcn_sched_barrier(0);
    f32x16 st;
#pragma unroll
    for (int i = 0; i < 16; ++i) st[i] = 0.f;
    __builtin_amdgcn_s_setprio(1);
#pragma unroll
    for (int s = 0; s < 4; ++s) st = MFMA32(kf[s], qf[s], st);
    __builtin_amdgcn_s_setprio(0);
    bf16x8 vf0[2], vf1[2];
    const LAS unsigned char* vl = vt_lane(vt, l31, hi);
#pragma unroll
    for (int t = 0; t < 2; ++t) { const int ko = (kb0 + 16 * t) * VT_PITCH; vf0[t] = vt_frag(vl, ko); vf1[t] = vt_frag(vl, ko + 64); }
    __builtin_amdgcn_sched_barrier(0);
#pragma unroll
    for (int i = 0; i < 16; ++i) { const int kcc = (i & 3) + 8 * (i >> 2); const bool valid = (unsigned)(kcc - wcsr) < 16u; const float pe = __builtin_amdgcn_exp2f(st[i] + bias[i]); st[i] = valid ? pe : 0.f; }
    u32x4 onesw; onesw.x = 0x3f803f80u; onesw.y = 0x3f803f80u; onesw.z = 0x3f803f80u; onesw.w = 0x3f803f80u;
    const bf16x8 ones = __builtin_bit_cast(bf16x8, onesw);
#pragma unroll
    for (int t = 0; t < 2; ++t) {
        u32x4 pw; pw.x = pk2(st[8 * t + 0], st[8 * t + 1]); pw.y = pk2(st[8 * t + 2], st[8 * t + 3]); pw.z = pk2(st[8 * t + 4], st[8 * t + 5]); pw.w = pk2(st[8 * t + 6], st[8 * t + 7]);
        const bf16x8 pf = __builtin_bit_cast(bf16x8, pw);
        __builtin_amdgcn_s_setprio(1);
        o0 = MFMA32(vf0[t], pf, o0);
        o1 = MFMA32(vf1[t], pf, o1);
        lacc = MFMA32(ones, pf, lacc);
        __builtin_amdgcn_s_setprio(0);
    }
}
__device__ __forceinline__ void attn_phase(LAS unsigned char* lds, const bf16_t* Q, const bf16_t* K, const bf16_t* V, bf16_t* O, const float* rpb, bool ctxq, int bid, int G, int revimg) {
    int tid_ = threadIdx.x; asm volatile("" : "+v"(tid_));
    const int tid = tid_, lane = tid & 63, w = __builtin_amdgcn_readfirstlane(tid >> 6), hi = lane >> 5, l31 = lane & 31;
    LAS float* rp = (LAS float*)(lds + AT_RPB);
    const int srow = tid >> 3, sch = tid & 7;
    const int nlat = NB * NH * 32;
    const int nun = nlat + (ctxq ? NB * NH : 0);
    const bool xmap = (G == 256);
    for (int it = 0; ; ++it) {
        int un = bid + it * G;
        if (un >= nun) break;
        const bool isctx = un >= nlat;
        int b, h, rq = 0, nwin = 0, kr_lo = 0, r_w = 0, rs_w = 0, qc = 0, r0 = 0, rs_lo = 0, rs_hi = 0, kb0 = 0; size_t tq;
        if (!isctx) {
            if (xmap) { int img = (bid & 7) + 8 * it; if (revimg) img = NB * NH - 1 - img; rq = bid >> 3; h = img & 15; b = img >> 4; }
            else { rq = un & 31; h = (un >> 5) & 15; b = un >> 9; }
            kr_lo = rstart(4 * rq); nwin = rstart(4 * rq + 3) + 8 - kr_lo;
            r0 = 4 * rq + 2 * (w >> 2); r_w = r0 + ((l31 >> 4) & 1); rs_w = rstart(r_w); qc = 16 * (w & 3) + (l31 & 15);
            rs_lo = rstart(r0); rs_hi = rstart(r0 + 1) + 8; kb0 = min(max(16 * (w & 3) - 8, 0), 32);
            tq = (size_t)b * SEQ + r_w * GW + qc; }
        else { const int v = un - nlat; h = v & 15; b = v >> 4; tq = (size_t)ML + b * CTX + 32 * w + l31; }
        const int T = nwin + 4;
        const int cs = min(max(qc - 8, 0), GW - 16);
        const int wcs = cs - kb0 - 4 * hi;
        bf16x8 qf[4];
        { const bf16_t* qp = Q + tq * D + 64 * h + 8 * hi;
#pragma unroll
          for (int s = 0; s < 4; ++s) qf[s] = *(const bf16x8*)(qp + 16 * s); }
        if (!isctx) for (int i = tid; i < 465; i += NTHR) rp[i] = rpb[h * 465 + i] * LOG2E;
        f32x16 o0, o1, lacc;
#pragma unroll
        for (int i = 0; i < 16; ++i) { o0[i] = 0.f; o1[i] = 0.f; lacc[i] = 0.f; }
        const size_t ctxbase = (size_t)ML + b * CTX, latbase = (size_t)b * SEQ;
        const size_t coloff = (size_t)srow * D + 64 * h + 8 * sch;
#define AT_TILE_OFF(jj) ((((jj) < nwin) ? latbase + (size_t)(kr_lo + (jj)) * GW : ctxbase + 64 * ((jj) - nwin)) * D + coloff)
#define AT_LOAD(kr_, vr_, jj) do { const size_t off_ = AT_TILE_OFF(jj); kr_ = *(const u32x4*)(K + off_); vr_ = *(const u32x4*)(V + off_); } while (0)
#define AT_WRITE(kr_, vr_, bufi) do { LAS unsigned char* kt_ = lds + AT_KT + (bufi) * KT_SZ; LAS unsigned char* vt_ = lds + AT_VT + (bufi) * VT_SZ; \
            *(LAS u32x4*)(kt_ + srow * 144 + sch * 16) = kr_; *(LAS u32x4*)(vt_ + srow * VT_PITCH + sch * 16) = vr_; } while (0)
#define AT_COMPUTE(jj, bufi) do { const LAS unsigned char* kt_ = lds + AT_KT + (bufi) * KT_SZ; const LAS unsigned char* vt_ = lds + AT_VT + (bufi) * VT_SZ; const int kr_ = kr_lo + (jj); \
            if ((jj) >= nwin) attn_tile<0>(kt_, vt_, rp, 0, qf, l31, hi, o0, o1, lacc); \
            else if (kr_ >= rs_lo && kr_ < rs_hi) { const LAS float* rpl_ = rp + ((kr_ - r_w + 7) * 31 + 15 - qc + kb0 + 4 * hi); \
                const int wcsr_ = ((unsigned)(kr_ - rs_w) < 8u) ? wcs : 4096;     \
                attn_wtile(kt_, vt_, rpl_, wcsr_, kb0, qf, l31, hi, o0, o1, lacc); } } while (0)
        u32x4 k0r, v0r, k1r, v1r;
        AT_LOAD(k0r, v0r, 0); AT_LOAD(k1r, v1r, 1);
        AT_WRITE(k0r, v0r, 0);
        __syncthreads();
        int j = 0;
        for (; j + 1 < T; j += 2) {
            { const int jl = min(j + 2, T - 1); AT_LOAD(k0r, v0r, jl); }
            AT_COMPUTE(j, 0);
            AT_WRITE(k1r, v1r, 1);
            __syncthreads();
            { const int jl = min(j + 3, T - 1); AT_LOAD(k1r, v1r, jl); }
            AT_COMPUTE(j + 1, 1);
            AT_WRITE(k0r, v0r, 0);
            __syncthreads();
        }
        if (j < T) { AT_COMPUTE(j, 0); __syncthreads(); }
#undef AT_TILE_OFF
#undef AT_LOAD
#undef AT_WRITE
#undef AT_COMPUTE
        const float inv = 1.0f / lacc[0];
        bf16_t* op = O + tq * D + 64 * h + 4 * hi;
#pragma unroll
        for (int g = 0; g < 4; ++g) { u32x2 wv; wv.x = pk2(o0[4 * g] * inv, o0[4 * g + 1] * inv); wv.y = pk2(o0[4 * g + 2] * inv, o0[4 * g + 3] * inv); *(u32x2*)(op + 8 * g) = wv;
            u32x2 wv1; wv1.x = pk2(o1[4 * g] * inv, o1[4 * g + 1] * inv); wv1.y = pk2(o1[4 * g + 2] * inv, o1[4 * g + 3] * inv); *(u32x2*)(op + 32 + 8 * g) = wv1; }
    }
}

#define XB_TMO      128
#define XB_XCNT(j)  (256  + 64 * (j))
#define XB_XSUB(j)  (1280 + 64 * (j))
#define XB_XGEN(j)  (2304 + 64 * (j))
#define XB_TOP      3328
#define XB_TOPGEN   3392
#define XCD_BAR_WORDS 3456
#define XB_SPIN_CAP (1u << 18)

__device__ __forceinline__ unsigned xb_ld(unsigned* p)              { return __hip_atomic_load(p, __ATOMIC_RELAXED, __HIP_MEMORY_SCOPE_AGENT); }
__device__ __forceinline__ unsigned xb_add(unsigned* p, unsigned v) { return __hip_atomic_fetch_add(p, v, __ATOMIC_RELAXED, __HIP_MEMORY_SCOPE_AGENT); }
__device__ __forceinline__ unsigned xb_xcc_id() { return (unsigned)__builtin_amdgcn_s_getreg((3 << 11) | 20) & 0xFu; }
#define XB_SPIN(cond, bar) do { unsigned _sp = 0; while (cond) { __builtin_amdgcn_s_sleep(1); \
    if ((++_sp & 255u) == 0u) { if (xb_ld(&(bar)[XB_TMO])) break; if (_sp > XB_SPIN_CAP) { atomicAdd(&(bar)[XB_TMO], 1u); break; } } } } while (0)

struct XcdBarrier {
    unsigned* bar; unsigned x;
    volatile LAS unsigned* st;
};

__device__ __forceinline__ XcdBarrier xcd_barrier_post(unsigned* bar, volatile LAS unsigned* st) {
    XcdBarrier b; b.bar = bar; b.x = xb_xcc_id(); b.st = st;
    if (threadIdx.x == 0) (void)xb_add(&bar[XB_XCNT(b.x)], 1u);
    return b;
}
__device__ __forceinline__ void xcd_barrier_complete(unsigned* bar, unsigned x, unsigned& nloc, unsigned& nx) {
    const unsigned G = gridDim.x * gridDim.y * gridDim.z;
    unsigned sum, cnt, mine, sp = 0u;
    for (;;) {
        sum = 0u; cnt = 0u; mine = 0u;
#pragma unroll
        for (unsigned j = 0; j < 16; ++j) { const unsigned c = xb_ld(&bar[XB_XCNT(j)]); sum += c; cnt += (c > 0u) ? 1u : 0u; mine = (j == x) ? c : mine; }
        if (sum == G) break;
        __builtin_amdgcn_s_sleep(1);
        if ((++sp & 255u) == 0u) { if (xb_ld(&bar[XB_TMO])) break; if (sp > XB_SPIN_CAP) { atomicAdd(&bar[XB_TMO], 1u); break; } }
    }
    nloc = mine > 0u ? mine : 1u; nx = cnt > 0u ? cnt : 1u;
}

__device__ __forceinline__ void xcd_barrier(const XcdBarrier& b) {
    asm volatile("s_waitcnt vmcnt(0)" ::: "memory");
    __syncthreads();
    if (threadIdx.x == 0) {
        unsigned* bar = b.bar;
        __builtin_amdgcn_s_waitcnt(0);
        unsigned nloc = b.st[0], nx = b.st[1];
        if (nloc == 0u) { xcd_barrier_complete(bar, b.x, nloc, nx); b.st[0] = nloc; b.st[1] = nx; }
        const unsigned old = xb_add(&bar[XB_XSUB(b.x)], 1u);
        const unsigned gen = old / nloc;
        if (old + 1u == (gen + 1u) * nloc) {
            __builtin_amdgcn_fence(__ATOMIC_RELEASE, "agent");
            asm volatile("s_waitcnt vmcnt(0)" ::: "memory");
            const unsigned og = xb_add(&bar[XB_TOP], 1u);
            const unsigned tg = og / nx;
            if (og + 1u == (tg + 1u) * nx) xb_add(&bar[XB_TOPGEN], 1u);
            else XB_SPIN(xb_ld(&bar[XB_TOPGEN]) == tg, bar);
            __builtin_amdgcn_fence(__ATOMIC_ACQUIRE, "agent");
            xb_add(&bar[XB_XGEN(b.x)], 1u);
            asm volatile("s_waitcnt vmcnt(0)" ::: "memory");
        } else {
            XB_SPIN(xb_ld(&bar[XB_XGEN(b.x)]) == gen, bar);
            __builtin_amdgcn_fence(__ATOMIC_ACQUIRE, "agent");
            asm volatile("s_waitcnt vmcnt(0)" ::: "memory");
        }
    }
    __syncthreads();
}

#ifndef REV_G1
#define REV_G1 1
#define REV_G2 0
#define REV_F1 1
#define REV_F2 0
#endif
#ifdef PROBE_SYNC2
#define GSYNC() do { xcd_barrier(xbar); xcd_barrier(xbar); } while (0)
#else
#define GSYNC() xcd_barrier(xbar)
#endif
__global__ void __launch_bounds__(NTHR, 2) mega_fwd(Params P) {
    extern __shared__ __attribute__((aligned(16))) unsigned char lds_raw[];
    LAS unsigned char* lds = (LAS unsigned char*)lds_raw;
    cg::grid_group grid = cg::this_grid();
    const int tid = threadIdx.x, lane = tid & 63, wave = __builtin_amdgcn_readfirstlane(tid >> 6);
    const int G = gridDim.x, bid = blockIdx.x;
    const int gw = bid * NWAVE + wave, ngw = G * NWAVE;
    unsigned char* ws = P.ws;
    volatile LAS unsigned* xst = (volatile LAS unsigned*)(lds + 131072);
    if (tid < 2) xst[tid] = 0u;
    __syncthreads();
    const XcdBarrier xbar = xcd_barrier_post((unsigned*)(ws + WS_BAR), xst);
    float* MOD = (float*)(ws + WS_MOD); float* SWM = (float*)(ws + WS_SWM); float* SWF = (float*)(ws + WS_SWF); float* RSS = (float*)(ws + WS_RSS); float* XC = (float*)(ws + WS_XC);
    bf16_t* XS = (bf16_t*)(ws + WS_XS); bf16_t* A0 = (bf16_t*)(ws + WS_A0); bf16_t* A1 = (bf16_t*)(ws + WS_A1); bf16_t* A2 = (bf16_t*)(ws + WS_A2); bf16_t* A3 = (bf16_t*)(ws + WS_A3); bf16_t* GG = (bf16_t*)(ws + WS_G);

#ifdef PROBE_PRO2
    for (int rep_ = 0; rep_ < 2; ++rep_) { if (rep_) GSYNC();
#endif
    {
        LAS float* vl = (LAS float*)lds; LAS float* red = (LAS float*)(lds + 49152);
        for (int idx = tid; idx < NS * D; idx += NTHR) { const int s = idx >> 10, k = idx & 1023; const float c = s < 8 ? P.in[I_C][s * D + k] : P.in[I_CCTX][k]; vl[k * 12 + s] = c / (1.0f + __expf(-c)); }
        __syncthreads();
        for (int task = bid; task < DEPTH * 48; task += G) { const int i = task / 48, cc = task % 48;
            gemv9_task(vl, red, P.in[I_WADA] + (size_t)i * D * 6144, 6144, cc * 128, MOD + (size_t)i * NS * 6144, 6144, P.in[I_BADA] + i * 6144); }
        for (int idx = bid * NTHR + tid; idx < 8 * MA; idx += G * NTHR) RSS[idx] = 0.f;
        __syncthreads();
        LAS float* scr = (LAS float*)(lds + wave * 16384);
        constexpr int IT_MIXIN = 16 * 96, IT_MIXOUT = 16 * 32, IT_FFNIN = 16 * 176, IT_FFNOUT = 44 * 32, IT_LAYER = IT_MIXIN + IT_MIXOUT + IT_FFNIN + IT_FFNOUT;
        for (int it = gw; it < DEPTH * IT_LAYER; it += ngw) {
            const int i = it / IT_LAYER; int r = it % IT_LAYER; const int j = i >> 1; const bool conv = (i & 1) == 0;
            unsigned char* wt = ws + WS_WT + (size_t)i * WT_LAYER;
            if (r < IT_MIXIN) { const int kb = r / 96, g = r % 96, pn = g >> 3, bj = (g >> 2) & 1, wc = g & 3;
                const int src0 = conv ? (pn < 4 ? 256 * pn + 128 * bj + 32 * wc : 1024 * (1 + bj) + 128 * (pn - 4) + 32 * wc) : (1024 * (pn >> 2) + 64 * (4 * (pn & 3) + wc) + 32 * bj);
                const float* W = conv ? P.in[I_CWIN] + (size_t)j * D * 3072 : P.in[I_AQKV] + (size_t)j * D * 3072;
                transpose_item(W, D, 3072, (bf16_t*)(wt + WT_MIXIN), src0, 32 * g, true, 64 * kb, scr, lane); continue; }
            r -= IT_MIXIN;
            if (r < IT_MIXOUT) { const int kb = r / 32, g = r % 32; const float* W = conv ? P.in[I_CWOUT] + (size_t)j * D * D : P.in[I_AWOUT] + (size_t)j * D * D;
                transpose_item(W, D, D, (bf16_t*)(wt + WT_MIXOUT), 32 * g, 32 * g, false, 64 * kb, scr, lane); continue; }
            r -= IT_MIXOUT;
            if (r < IT_FFNIN) { const int kb = r / 176, g = r % 176, pn = g >> 3, bj = (g >> 2) & 1, wc = g & 3; const int src0 = FF * bj + 128 * pn + 32 * wc;
                transpose_item(P.in[I_FWIN] + (size_t)i * D * 2 * FF, D, 2 * FF, (bf16_t*)(wt + WT_FFNIN), src0, 32 * g, true, 64 * kb, scr, lane); continue; }
            r -= IT_FFNIN;
            { const int kb = r / 32, g = r % 32; transpose_item(P.in[I_FWOUT] + (size_t)i * FF * D, FF, D, (bf16_t*)(wt + WT_FFNOUT), 32 * g, 32 * g, false, 64 * kb, scr, lane); }
        }
    }
#ifdef PROBE_PRO2
    }
#endif
    if (P.ws == nullptr) grid.sync();
    GSYNC();
#ifdef PROBE_PRO2
    for (int rep_ = 0; rep_ < 2; ++rep_) { if (rep_) GSYNC();
#endif
    {
        LAS float* vl = (LAS float*)lds; LAS float* red = (LAS float*)(lds + 49152);
        for (int task = bid; task < DEPTH * 68; task += G) { const int i = task / 68; int r = task % 68; const int j = i >> 1;
            const bool mix = r < 24; const int voff = mix ? 0 : 3 * D;
            for (int idx = tid; idx < NS * D; idx += NTHR) { const int s = idx >> 10, k = idx & 1023; vl[k * 12 + s] = MOD[(size_t)(i * NS + s) * 6144 + voff + k]; }
            __syncthreads();
            if (mix) { const float* W = (i & 1) == 0 ? P.in[I_CWIN] + (size_t)j * D * 3072 : P.in[I_AQKV] + (size_t)j * D * 3072;
                gemv9_task(vl, red, W, 3072, r * 128, SWM + (size_t)i * NS * 3072, 3072, nullptr); }
            else { r -= 24; gemv9_task(vl, red, P.in[I_FWIN] + (size_t)i * D * 2 * FF, 2 * FF, r * 128, SWF + (size_t)i * NS * 2 * FF, 2 * FF, nullptr); }
        }
        for (int row0 = gw; row0 < MA; row0 += 4 * ngw) {
            f32x4 v[4][4];
#pragma unroll
            for (int r = 0; r < 4; ++r) { const int row = min(row0 + r * ngw, MA - 1); const bool lat = row < ML;
                const float* src = lat ? P.in[I_X] + (size_t)row * D : P.in[I_CTX] + (size_t)(row - ML) * D;
#pragma unroll
                for (int q = 0; q < 4; ++q) v[r][q] = ((const f32x4*)src)[lane + 64 * q]; }
            asm volatile("" ::: "memory");
#pragma unroll
            for (int r = 0; r < 4; ++r) { const int row = row0 + r * ngw; if (row < MA) { const bool lat = row < ML; const int s = lat ? (row >> 13) : 8;
                float ss = 0.f;
#pragma unroll
                for (int q = 0; q < 4; ++q) ss += (v[r][q][0] * v[r][q][0] + v[r][q][1] * v[r][q][1]) + (v[r][q][2] * v[r][q][2] + v[r][q][3] * v[r][q][3]);
                ss = wave_sum(ss);
                if (lane == 0) RSS[row] = ss;
#pragma unroll
                for (int q = 0; q < 4; ++q) { const int c = 4 * (lane + 64 * q); const f32x4 nv = *(const f32x4*)(P.in[I_NMIX] + c) * (*(const f32x4*)(MOD + (size_t)s * 6144 + D + c) + 1.0f); const f32x4 y = v[r][q] * nv;
                    u32x2 wv; wv.x = pk2(y[0], y[1]); wv.y = pk2(y[2], y[3]); *(u32x2*)(XS + (size_t)row * D + c) = wv; } } }
        }
    }
#ifdef PROBE_PRO2
    }
#endif
    GSYNC();
    int dirw = 0;
    for (int i = 0; i < DEPTH; ++i) {
        const int j = i >> 1; const bool conv = (i & 1) == 0; const bool last = i == DEPTH - 1;
        unsigned char* wt = ws + WS_WT + (size_t)i * WT_LAYER;
        const float* modi = MOD + (size_t)i * NS * 6144;
        float* rssA = RSS + (size_t)(2 * i) * MA; float* rssB = RSS + (size_t)(2 * i + 1) * MA;
        const int Mr = last ? ML : MA;
        const float* xin_l = i == 0 ? P.in[I_X] : P.out; const float* xin_c = i == 0 ? P.in[I_CTX] : XC;
        if (conv) {
            { pg8::Gemm g{XS, (const bf16_t*)(wt + WT_MIXIN), MA, 3072, D}; pg8::StaticOrder S; S.init(MA, 3072, G, bid); S.rev = !dirw; dirw = S.rev;
              EpiConvIn E{rssA, SWM + (size_t)i * NS * 3072, A0, A1};
#ifndef SKIP_G1C
              pg8::gemm_phase<EpiConvIn, pg8::StaticOrder, true, true>(lds, g, S, E);
#ifdef PROBE_GEMM2
              pg8::gemm_phase<EpiConvIn, pg8::StaticOrder, true, true>(lds, g, S, E);
#endif
#endif
 }
            GSYNC();
#ifndef SKIP_CONV
            conv_phase(A0, A1, A3, P.in[I_CW] + (size_t)j * 3 * D, gw, ngw, lane);
#ifdef PROBE_CONV2
            GSYNC();
            conv_phase(A0, A1, A3, P.in[I_CW] + (size_t)j * 3 * D, gw, ngw, lane);
#endif
#endif
            GSYNC();
        } else {
            { pg8::Gemm g{XS, (const bf16_t*)(wt + WT_MIXIN), MA, 3072, D}; pg8::StaticOrder S; S.init(MA, 3072, G, bid); S.rev = !dirw; dirw = S.rev;
              EpiQKV E{rssA, SWM + (size_t)i * NS * 3072, P.in[I_AQN] + j * HD, P.in[I_AKN] + j * HD, A0};
#ifndef SKIP_G1Q
              pg8::gemm_phase<EpiQKV, pg8::StaticOrder, true, true>(lds, g, S, E);
#ifdef PROBE_GEMM2
              pg8::gemm_phase<EpiQKV, pg8::StaticOrder, true, true>(lds, g, S, E);
#endif
#endif
 }
            GSYNC();
#ifndef SKIP_ATTN
            dirw = !dirw;
            attn_phase(lds, A0, A1, A2, A3, P.in[I_ARPB] + (size_t)j * NH * 465, !last, bid, G, dirw);
#ifdef PROBE_ATTN2
            GSYNC();
            attn_phase(lds, A0, A1, A2, A3, P.in[I_ARPB] + (size_t)j * NH * 465, !last, bid, G, dirw);
#endif
#endif
            GSYNC();
        }
        { pg8::Gemm g{A3, (const bf16_t*)(wt + WT_MIXOUT), Mr, D, D}; pg8::StaticOrder S; S.init(Mr, D, G, bid); S.rev = !dirw; dirw = S.rev;
          EpiRes E{xin_l, xin_c, P.out, XC, modi + 2 * D, P.in[I_NFFN] + i * D, modi + 4 * D, XS, rssB};
#ifndef SKIP_G2
#ifdef PROBE_RES2
          { EpiRes E2{xin_l, xin_c, (float*)A0, (float*)A0 + (size_t)ML * D, modi + 2 * D, nullptr, modi + 4 * D, XS, rssB};
            pg8::gemm_phase<EpiRes, pg8::StaticOrder, true, true>(lds, g, S, E2); GSYNC(); }
#endif
          pg8::gemm_phase<EpiRes, pg8::StaticOrder, false, true>(lds, g, S, E);
#endif
 }
        GSYNC();
        { pg8::Gemm g{XS, (const bf16_t*)(wt + WT_FFNIN), Mr, 2 * FF, D}; pg8::StaticOrder S; S.init(Mr, 2 * FF, G, bid); S.rev = !dirw; dirw = S.rev;
          EpiSwi E{rssB, SWF + (size_t)i * NS * 2 * FF, GG};
#ifndef SKIP_F1
          pg8::gemm_phase<EpiSwi, pg8::StaticOrder, true, true>(lds, g, S, E);
#ifdef PROBE_GEMM2
          pg8::gemm_phase<EpiSwi, pg8::StaticOrder, true, true>(lds, g, S, E);
#endif
#endif
 }
        GSYNC();
        { pg8::Gemm g{GG, (const bf16_t*)(wt + WT_FFNOUT), Mr, D, FF}; pg8::StaticOrder S; S.init(Mr, D, G, bid); S.rev = !dirw; dirw = S.rev;
          EpiRes E{P.out, XC, P.out, XC, modi + 5 * D, last ? nullptr : P.in[I_NMIX] + (i + 1) * D, modi + NS * 6144 + D, XS, rssA + 2 * MA};
#ifndef SKIP_F2
#ifdef PROBE_RES2
          { EpiRes E2{P.out, XC, P.out, XC, (const float*)(ws + WS_ZERO), nullptr, modi + 4 * D, XS, rssB};
            pg8::gemm_phase<EpiRes, pg8::StaticOrder, true, true>(lds, g, S, E2); GSYNC(); }
#endif
          pg8::gemm_phase<EpiRes, pg8::StaticOrder, false, true>(lds, g, S, E);
#endif
 }
        if (!last) GSYNC();
    }
}

extern "C" void kernel_launch(void* const* d_in, const int* in_sizes, int n_in, void* d_out, int out_size, void* d_ws, size_t ws_size, hipStream_t stream) {
    static int grid = 0;
    if (grid == 0) {
        if (n_in != 18 || out_size != ML * D || ws_size < WS_END) { fprintf(stderr, "kernel_launch: unexpected shapes (n_in %d, out %d, ws %zu, need %zu)\n", n_in, out_size, ws_size, (size_t)WS_END); grid = -1; return; }
        int dev = 0, cus = 0, per_cu = 0;
        if (hipGetDevice(&dev) != hipSuccess || hipDeviceGetAttribute(&cus, hipDeviceAttributeMultiprocessorCount, dev) != hipSuccess) { grid = -1; return; }
        if (hipFuncSetAttribute((const void*)mega_fwd, hipFuncAttributeMaxDynamicSharedMemorySize, LDS_BYTES) != hipSuccess) { fprintf(stderr, "kernel_launch: hipFuncSetAttribute failed\n"); grid = -1; return; }
        if (hipOccupancyMaxActiveBlocksPerMultiprocessor(&per_cu, (const void*)mega_fwd, NTHR, LDS_BYTES) != hipSuccess || per_cu < 1) { fprintf(stderr, "kernel_launch: occupancy query says %d\n", per_cu); per_cu = 1; }
        (void)hipGetLastError();
        grid = cus;
    }
    if (grid < 0) return;
    if (hipMemsetAsync((char*)d_ws + WS_BAR, 0, BAR_BYTES, stream) != hipSuccess) { fprintf(stderr, "kernel_launch: memset failed\n"); return; }
#ifdef PROBE_RES2
    (void)hipMemsetAsync((char*)d_ws + WS_ZERO, 0, ZERO_BYTES, stream);
#endif
    Params p{};
    for (int i = 0; i < 18; ++i) p.in[i] = (const float*)d_in[i];
    p.out = (float*)d_out; p.ws = (unsigned char*)d_ws;
    void* args[] = {&p};
    hipError_t e = hipLaunchCooperativeKernel((const void*)mega_fwd, dim3(grid), dim3(NTHR), args, LDS_BYTES, stream);
    if (e != hipSuccess) fprintf(stderr, "kernel_launch: cooperative launch failed: %s (grid %d)\n", hipGetErrorString(e), grid);
}
```
